# Optimizing an MI355X kernel written in HIP

```python
import jax, jax.numpy as jnp
from jax import lax
import numpy as np

D_MODEL = 2048
BATCH = 4
SEQ = 8192
DEPTH = 1

CHUNK = 64
MIX_WIDTH = D_MODEL
LRU_WIDTH = MIX_WIDTH // 2
LRU_HEADS = 4
LRU_HEAD_DIM = LRU_WIDTH // LRU_HEADS
LRU_CONV = 4
LRU_C = 8.0
SC_WIDTH = MIX_WIDTH - LRU_WIDTH
SC_GROUPS = 8
SC_CONV = 3
IN_COLS = 2 * LRU_WIDTH + 3 * SC_WIDTH
N_GROUPS = 4
EXPERTS_PER_GROUP = 8
N_EXPERTS = N_GROUPS * EXPERTS_PER_GROUP
TOP_K = 2
D_FF_EXPERT = D_MODEL // 2
MOE_BLOCK = 128
EPS = 1e-6

kernel_name = "hymba_rglru_shortconv_hmoe_adaln"


def rms_norm(x, g):
    xf = x.astype(jnp.float32)
    return xf * lax.rsqrt(jnp.mean(xf * xf, axis=-1, keepdims=True) + EPS) * g.astype(jnp.float32)


def group_rms_norm(y, g, n_groups):
    bn, s, ch = y.shape
    yg = y.astype(jnp.float32).reshape(bn, s, n_groups, ch // n_groups)
    yg = yg * lax.rsqrt(jnp.mean(yg * yg, axis=-1, keepdims=True) + EPS)
    return yg.reshape(bn, s, ch) * g.astype(jnp.float32)


def modulate(h, shift, scale):
    return h * (1.0 + scale[:, None, :]) + shift[:, None, :]


def causal_dwconv(x, w):
    width = w.shape[0]
    s = x.shape[1]
    xp = jnp.pad(x, ((0, 0), (width - 1, 0), (0, 0)))
    y = xp[:, 0:s] * w[0]
    for k in range(1, width):
        y = y + xp[:, k:k + s] * w[k]
    return y


def chunked_linear_scan(a, u):
    bn, s, ch = a.shape
    n_chunks = s // CHUNK
    a_c = a.reshape(bn, n_chunks, CHUNK, ch)
    u_c = u.reshape(bn, n_chunks, CHUNK, ch)

    def combine(left, right):
        a_l, u_l = left
        a_r, u_r = right
        return a_l * a_r, a_r * u_l + u_r

    a_cum, h_loc = lax.associative_scan(combine, (a_c, u_c), axis=2)

    def step(h, inp):
        a_end, h_end = inp
        return a_end * h + h_end, h

    a_end = jnp.transpose(a_cum[:, :, -1], (1, 0, 2))
    h_end = jnp.transpose(h_loc[:, :, -1], (1, 0, 2))
    _, h_in = lax.scan(step, jnp.zeros((bn, ch), jnp.float32), (a_end, h_end))
    h_in = jnp.transpose(h_in, (1, 0, 2))
    h = h_loc + a_cum * h_in[:, :, None, :]
    return h.reshape(bn, s, ch)


def rg_lru(x, w_a, b_a, w_x, b_x, lam):
    bn, s, ch = x.shape
    xh = x.reshape(bn, s, LRU_HEADS, LRU_HEAD_DIM)
    r = jax.nn.sigmoid(jnp.einsum('bshi,hij->bshj', xh, w_a).reshape(bn, s, ch) + b_a)
    i = jax.nn.sigmoid(jnp.einsum('bshi,hij->bshj', xh, w_x).reshape(bn, s, ch) + b_x)
    log_a = -LRU_C * r * jax.nn.softplus(-lam.astype(jnp.float32))
    a = jnp.exp(log_a)
    mult = jnp.sqrt(-jnp.expm1(2.0 * log_a))
    return chunked_linear_scan(a, mult * (i * x))


def hier_moe(h, w_rg, b_rg, w_re, b_re, w1, w3, w2):
    bn, s, d = h.shape
    n_tok = bn * s
    t = h.reshape(n_tok, d)
    tf = t.astype(jnp.float32)
    g_prob = jax.nn.softmax(tf @ w_rg + b_rg, axis=-1)
    g_p, g_idx = lax.top_k(g_prob, 1)
    e_logits = (tf @ w_re + b_re).reshape(n_tok, N_GROUPS, EXPERTS_PER_GROUP)
    e_logits = jnp.einsum('nge,ng->ne', e_logits, jax.nn.one_hot(g_idx[:, 0], N_GROUPS, dtype=jnp.float32))
    e_prob = jax.nn.softmax(e_logits, axis=-1)
    e_p, e_idx = lax.top_k(e_prob, TOP_K)
    e_p = e_p / jnp.sum(e_p, axis=-1, keepdims=True)
    gate = g_p * e_p
    expert = g_idx * EXPERTS_PER_GROUP + e_idx

    n_assign = n_tok * TOP_K
    flat_e = expert.reshape(n_assign)
    flat_t = jnp.repeat(jnp.arange(n_tok, dtype=jnp.int32), TOP_K)
    flat_w = gate.reshape(n_assign)
    order = jnp.argsort(flat_e)
    se = flat_e[order]
    counts = jnp.bincount(flat_e, length=N_EXPERTS)
    padded = ((counts + MOE_BLOCK - 1) // MOE_BLOCK) * MOE_BLOCK
    starts = jnp.cumsum(counts) - counts
    pends = jnp.cumsum(padded)
    pstarts = pends - padded
    dest = pstarts[se] + jnp.arange(n_assign, dtype=jnp.int32) - starts[se]
    n_blocks = -(-n_assign // MOE_BLOCK) + N_EXPERTS
    n_slots = n_blocks * MOE_BLOCK
    slot_tok = jnp.zeros((n_slots,), jnp.int32).at[dest].set(flat_t[order])
    slot_w = jnp.zeros((n_slots,), jnp.float32).at[dest].set(flat_w[order])
    block_e = jnp.minimum(
        jnp.searchsorted(pends, jnp.arange(n_blocks, dtype=jnp.int32) * MOE_BLOCK, side='right'),
        N_EXPERTS - 1)
    xb = t[slot_tok].reshape(n_blocks, MOE_BLOCK, d)

    def expert_block(args):
        xblk, e = args
        hid = jax.nn.silu(xblk @ w1[e]) * (xblk @ w3[e])
        return hid @ w2[e]

    yb = lax.map(expert_block, (xb, block_e))
    y = yb.reshape(n_slots, d).astype(jnp.float32) * slot_w[:, None]
    out = jax.ops.segment_sum(y, slot_tok, num_segments=n_tok)
    return out.reshape(bn, s, d)


def setup_inputs(seed: int = 0) -> dict:
    key = jax.random.key(seed)
    ks = jax.random.split(key, 26)
    f32 = jnp.float32
    D, L = D_MODEL, DEPTH

    def nrm(k, shape, scale):
        return jax.random.normal(k, shape, f32) * scale

    a0 = jax.random.uniform(ks[12], (L, LRU_WIDTH), f32, 0.9, 0.999)
    return {
        "x": jax.random.normal(ks[0], (BATCH, SEQ, D), f32),
        "c": jax.random.normal(ks[1], (BATCH, D), f32),
        "w_ada": nrm(ks[2], (L, D, 6 * D), 0.5 * D ** -0.5),
        "b_ada": nrm(ks[3], (L, 6 * D), 0.02),
        "g_mix": 1.0 + nrm(ks[4], (L, D), 0.1),
        "w_in": nrm(ks[5], (L, D, IN_COLS), D ** -0.5),
        "lru_conv_w": nrm(ks[6], (L, LRU_CONV, LRU_WIDTH), LRU_CONV ** -0.5),
        "lru_conv_b": nrm(ks[7], (L, LRU_WIDTH), 0.02),
        "lru_w_a": nrm(ks[8], (L, LRU_HEADS, LRU_HEAD_DIM, LRU_HEAD_DIM), LRU_HEAD_DIM ** -0.5),
        "lru_b_a": nrm(ks[9], (L, LRU_WIDTH), 0.02),
        "lru_w_x": nrm(ks[10], (L, LRU_HEADS, LRU_HEAD_DIM, LRU_HEAD_DIM), LRU_HEAD_DIM ** -0.5),
        "lru_b_x": nrm(ks[11], (L, LRU_WIDTH), 0.02),
        "lru_lambda": jnp.log(a0) - jnp.log1p(-a0),
        "lru_out_g": 1.0 + nrm(ks[13], (L, LRU_WIDTH), 0.1),
        "sc_conv_w": nrm(ks[14], (L, SC_CONV, SC_WIDTH), SC_CONV ** -0.5),
        "sc_out_g": 1.0 + nrm(ks[15], (L, SC_WIDTH), 0.1),
        "w_out": nrm(ks[16], (L, MIX_WIDTH, D), MIX_WIDTH ** -0.5),
        "g_ffn": 1.0 + nrm(ks[17], (L, D), 0.1),
        "w_router_group": nrm(ks[18], (L, D, N_GROUPS), D ** -0.5),
        "b_router_group": nrm(ks[19], (L, N_GROUPS), 0.01),
        "w_router_expert": nrm(ks[20], (L, D, N_EXPERTS), D ** -0.5),
        "b_router_expert": nrm(ks[21], (L, N_EXPERTS), 0.01),
        "w1": nrm(ks[22], (L, N_EXPERTS, D, D_FF_EXPERT), D ** -0.5),
        "w3": nrm(ks[23], (L, N_EXPERTS, D, D_FF_EXPERT), D ** -0.5),
        "w2": nrm(ks[24], (L, N_EXPERTS, D_FF_EXPERT, D), D_FF_EXPERT ** -0.5),
        "g_final": 1.0 + nrm(ks[25], (D,), 0.1),
    }


def reference(x, c, w_ada, b_ada, g_mix, w_in, lru_conv_w, lru_conv_b, lru_w_a, lru_b_a,
              lru_w_x, lru_b_x, lru_lambda, lru_out_g, sc_conv_w, sc_out_g, w_out, g_ffn,
              w_router_group, b_router_group, w_router_expert, b_router_expert,
              w1, w3, w2, g_final):
    out_dtype = x.dtype
    cond = jax.nn.silu(c.astype(jnp.float32))
    split_cols = [LRU_WIDTH, 2 * LRU_WIDTH, 2 * LRU_WIDTH + SC_WIDTH, 2 * LRU_WIDTH + 2 * SC_WIDTH]
    for l in range(DEPTH):
        mod = cond @ w_ada[l] + b_ada[l]
        sh1, sc1, gt1, sh2, sc2, gt2 = jnp.split(mod, 6, axis=-1)

        h = modulate(rms_norm(x, g_mix[l]), sh1, sc1)
        proj = h @ w_in[l]
        x_lru, gate_lru, b_sc, c_sc, x_sc = jnp.split(proj, split_cols, axis=-1)

        x_lru = causal_dwconv(x_lru, lru_conv_w[l]) + lru_conv_b[l]
        h_lru = rg_lru(x_lru.astype(jnp.float32), lru_w_a[l], lru_b_a[l],
                       lru_w_x[l], lru_b_x[l], lru_lambda[l])
        y_lru = group_rms_norm(h_lru * jax.nn.gelu(gate_lru), lru_out_g[l], LRU_HEADS)

        y_sc = b_sc * causal_dwconv(c_sc * x_sc, sc_conv_w[l])
        y_sc = group_rms_norm(y_sc, sc_out_g[l], SC_GROUPS)

        mix = jnp.concatenate([y_lru, y_sc], axis=-1) @ w_out[l]
        x = x + gt1[:, None, :] * mix

        h2 = modulate(rms_norm(x, g_ffn[l]), sh2, sc2)
        ffn = hier_moe(h2, w_router_group[l], b_router_group[l], w_router_expert[l],
                       b_router_expert[l], w1[l], w3[l], w2[l])
        x = x + gt2[:, None, :] * ffn
    return rms_norm(x, g_final).astype(out_dtype)
```

```cpp
#include <hip/hip_runtime.h>
#include <cstdio>
#include <cstdint>

#ifndef MK_N_LAUNCHES
#define MK_N_LAUNCHES 1
#endif
constexpr int N_PHASES = 10;

constexpr int DM = 2048, NB = 4, SEQ = 8192, NTOK = NB * SEQ;
constexpr int LRU_W = 1024, LRU_HD = 256, SC_W = 1024, IN_COLS = 5120;
constexpr int NEXP = 32, FF = 1024;
constexpr int LIST_CAP = NTOK;
constexpr float EPS = 1e-6f;
constexpr int MAX_TILES = 288;

constexpr size_t MiB = 1u << 20;
constexpr size_t WS_CTL = 0, CTL_ZERO_BYTES = 65536;
constexpr size_t WS_MOD = 1 * MiB;
constexpr size_t WS_CAR = 2 * MiB;
constexpr size_t WS_WRT = 4 * MiB;
constexpr size_t WS_LTOK = 5 * MiB;
constexpr size_t WS_LGATE = 9 * MiB;
constexpr size_t WS_TOKSLOT = 13 * MiB;
constexpr size_t WS_WLRU = 14 * MiB;
constexpr size_t WS_WIN = 16 * MiB;
constexpr size_t WS_WOUT = 36 * MiB;
constexpr size_t WS_W13 = 44 * MiB;
constexpr size_t WS_X1B = 172 * MiB;
constexpr size_t WS_W2 = 300 * MiB;
constexpr size_t WS_H = 428 * MiB;
constexpr size_t WS_PROJ = 556 * MiB;
constexpr size_t WS_YCAT = 876 * MiB;
constexpr size_t WS_ROWSS = 556 * MiB;
constexpr size_t WS_HID = 556 * MiB;
constexpr size_t WS_YEXP = 700 * MiB;
constexpr size_t WS_END = 1004 * MiB;
constexpr int CW_GCNT = 64;
constexpr int CW_BAR = 4096;

constexpr int LDS_BYTES = 160 * 1024;
constexpr int LDS_MISC = 156 * 1024;
constexpr int LDS_TAB = 152 * 1024;

#define GAS __attribute__((address_space(1)))
#define LAS __attribute__((address_space(3)))
typedef unsigned short bf16;
typedef unsigned v4u __attribute__((ext_vector_type(4)));
typedef unsigned v2u __attribute__((ext_vector_type(2)));
typedef float f32x4 __attribute__((ext_vector_type(4)));
typedef float f32x2 __attribute__((ext_vector_type(2)));
typedef short bf16x8 __attribute__((ext_vector_type(8)));
#define LDS_WAIT() asm volatile("s_waitcnt lgkmcnt(0)" ::: "memory")
#define VM_WAIT() asm volatile("s_waitcnt vmcnt(0)" ::: "memory")

__device__ __forceinline__ unsigned f2bf(float f) { unsigned u = __builtin_bit_cast(unsigned, f); return (u + 0x7fffu + ((u >> 16) & 1u)) >> 16; }
__device__ __forceinline__ unsigned pk2(float lo, float hi) { return f2bf(lo) | (f2bf(hi) << 16); }
__device__ __forceinline__ float bf2f(unsigned b) { return __builtin_bit_cast(float, b << 16); }
__device__ __forceinline__ float bflo(unsigned w) { return __builtin_bit_cast(float, w << 16); }
__device__ __forceinline__ float bfhi(unsigned w) { return __builtin_bit_cast(float, w & 0xffff0000u); }
__device__ __forceinline__ unsigned cvt_pk_bf16(float lo, float hi) { unsigned r; asm volatile("v_cvt_pk_bf16_f32 %0, %1, %2" : "=v"(r) : "v"(lo), "v"(hi)); return r; }
typedef int v4i __attribute__((ext_vector_type(4)));
typedef int v8i __attribute__((ext_vector_type(8)));
constexpr float FP8_MAX = 448.0f;
constexpr float F8S_W = 256.0f, F8S_H2 = 16.0f, F8S_HID = 8.0f, F8S_Y = 32.0f;
__device__ __forceinline__ float clamp8(float x) { return fminf(fmaxf(x, -FP8_MAX), FP8_MAX); }
__device__ __forceinline__ unsigned pack4_fp8(float a, float b, float c, float d) { int p = __builtin_amdgcn_cvt_pk_fp8_f32(clamp8(a), clamp8(b), 0, false); p = __builtin_amdgcn_cvt_pk_fp8_f32(clamp8(c), clamp8(d), p, true); return (unsigned)p; }
__device__ __forceinline__ float fast_sigmoid(float x) { return __builtin_amdgcn_rcpf(1.0f + __builtin_amdgcn_exp2f(-1.4426950408889634f * x)); }
__device__ __forceinline__ float wave_sum(float v) {
#pragma unroll
    for (int o = 1; o < 64; o <<= 1) v += __shfl_xor(v, o);
    return v;
}

#define XB_TMO      128
#define XB_XCNT(j)  (256  + 64 * (j))
#define XB_XSUB(j)  (1280 + 64 * (j))
#define XB_XGEN(j)  (2304 + 64 * (j))
#define XB_TOP      3328
#define XB_TOPGEN   3392
#define XCD_BAR_WORDS 3456
#define XB_SPIN_CAP (1u << 18)
__device__ __forceinline__ unsigned xb_ld(unsigned* p)              { return __hip_atomic_load(p, __ATOMIC_RELAXED, __HIP_MEMORY_SCOPE_AGENT); }
__device__ __forceinline__ unsigned xb_add(unsigned* p, unsigned v) { return __hip_atomic_fetch_add(p, v, __ATOMIC_RELAXED, __HIP_MEMORY_SCOPE_AGENT); }
__device__ __forceinline__ unsigned xb_xcc_id() { return (unsigned)__builtin_amdgcn_s_getreg((3 << 11) | 20) & 0xFu; }
#define XB_SPIN(cond, bar) do { unsigned _sp = 0; while (cond) { __builtin_amdgcn_s_sleep(1); \
    if ((++_sp & 255u) == 0u) { if (xb_ld(&(bar)[XB_TMO])) break; if (_sp > XB_SPIN_CAP) { atomicAdd(&(bar)[XB_TMO], 1u); break; } } } } while (0)
struct XcdBarrier { unsigned* bar; unsigned x; volatile LAS unsigned* st; };
__device__ __forceinline__ XcdBarrier xcd_barrier_post(unsigned* bar, volatile LAS unsigned* st) {
    XcdBarrier b; b.bar = bar; b.x = xb_xcc_id(); b.st = st;
    if (threadIdx.x == 0) (void)xb_add(&bar[XB_XCNT(b.x)], 1u);
    return b;
}
__device__ __forceinline__ void xcd_barrier_complete(unsigned* bar, unsigned x, unsigned& nloc, unsigned& nx) {
    const unsigned G = gridDim.x * gridDim.y * gridDim.z;
    unsigned sum, cnt, mine, sp = 0u;
    for (;;) {
        sum = 0u; cnt = 0u; mine = 0u;
#pragma unroll
        for (unsigned j = 0; j < 16; ++j) { const unsigned c = xb_ld(&bar[XB_XCNT(j)]); sum += c; cnt += (c > 0u) ? 1u : 0u; mine = (j == x) ? c : mine; }
        if (sum == G) break;
        __builtin_amdgcn_s_sleep(1);
        if ((++sp & 255u) == 0u) { if (xb_ld(&bar[XB_TMO])) break; if (sp > XB_SPIN_CAP) { atomicAdd(&bar[XB_TMO], 1u); break; } }
    }
    nloc = mine > 0u ? mine : 1u; nx = cnt > 0u ? cnt : 1u;
}
__device__ __forceinline__ void xcd_barrier(const XcdBarrier& b) {
    asm volatile("s_waitcnt vmcnt(0)" ::: "memory");
    __syncthreads();
    if (threadIdx.x == 0) {
        unsigned* bar = b.bar;
        __builtin_amdgcn_s_waitcnt(0);
        unsigned nloc = b.st[0], nx = b.st[1];
        if (nloc == 0u) { xcd_barrier_complete(bar, b.x, nloc, nx); b.st[0] = nloc; b.st[1] = nx; }
        const unsigned old = xb_add(&bar[XB_XSUB(b.x)], 1u);
        const unsigned gen = old / nloc;
        if (old + 1u == (gen + 1u) * nloc) {
            __builtin_amdgcn_fence(__ATOMIC_RELEASE, "agent");
            asm volatile("s_waitcnt vmcnt(0)" ::: "memory");
            const unsigned og = xb_add(&bar[XB_TOP], 1u);
            const unsigned tg = og / nx;
            if (og + 1u == (tg + 1u) * nx) xb_add(&bar[XB_TOPGEN], 1u);
            else XB_SPIN(xb_ld(&bar[XB_TOPGEN]) == tg, bar);
            __builtin_amdgcn_fence(__ATOMIC_ACQUIRE, "agent");
            xb_add(&bar[XB_XGEN(b.x)], 1u);
            asm volatile("s_waitcnt vmcnt(0)" ::: "memory");
        } else {
            XB_SPIN(xb_ld(&bar[XB_XGEN(b.x)]) == gen, bar);
            __builtin_amdgcn_fence(__ATOMIC_ACQUIRE, "agent");
            asm volatile("s_waitcnt vmcnt(0)" ::: "memory");
        }
    }
    __syncthreads();
}

namespace pg8 {
#ifndef PG8_ROLL_ALL
#define PG8_ROLL_ALL false
#endif
constexpr bool ROLL_ALL = PG8_ROLL_ALL;
constexpr int BM = 256, BK = 64, HALF = 128, HTB = HALF * BK * 2, STAGE_BYTES = 8 * HTB, NXCD = 8, WGM = 8;
__host__ __device__ __forceinline__ int lds_byte(int r, int c) { const int st = (r >> 4) * 2 + (c >> 5), rr = r & 15, cc = c & 31, ob = rr * 64 + cc * 2; return st * 1024 + (ob ^ (((ob >> 9) & 1) << 5)); }
__host__ __device__ __forceinline__ void stage_rc(int b, int& R, int& C) { const int st = b / 1024, sb = b % 1024, swz = sb ^ (((sb >> 9) & 1) << 5); R = (st >> 1) * 16 + swz / 64; C = (st & 1) * 32 + (swz % 64) / 2; }
__host__ __device__ __forceinline__ int perm32(int rho) { const int n = rho >> 4, i = rho & 15; return 8 * (i >> 2) + 4 * n + (i & 3); }

struct Unit {
    const char* aBase;
    const char* bBase;
    int row0, col0;
    int gbase, nvalid;
};

template <int KB>
struct DenseOrder {
    const char* A; const char* Bt; int nM, nN, nwg, G, c;
    __device__ __forceinline__ void init(const void* A_, const void* Bt_, int M, int N, int G_, int c_) { A = (const char*)A_; Bt = (const char*)Bt_; nM = M / BM; nN = N / BM; nwg = nM * nN; G = G_; c = c_; }
    __device__ __forceinline__ bool next(int i, Unit& u) const {
        const long L = (long)i * G + c; if (L >= nwg) return false;
        int wgid = (int)L; { const int q = nwg / NXCD, r = nwg % NXCD, xcd = wgid % NXCD, off = wgid / NXCD; wgid = (xcd < r ? xcd * (q + 1) : r * (q + 1) + (xcd - r) * q) + off; }
        const int nig = WGM * nN, gid = wgid / nig, fm = gid * WGM, gsz = (nM - fm) < WGM ? (nM - fm) : WGM;
        const int pm = fm + ((wgid % nig) % gsz), pn = (wgid % nig) / gsz;
        u.row0 = pm * BM; u.col0 = pn * BM; u.aBase = A + (size_t)pm * BM * KB; u.bBase = Bt + (size_t)pn * BM * KB; u.gbase = 0; u.nvalid = BM; return true;
    }
};
template <int KB, int NPN, int COLSTEP, bool GATHER_A>
struct MoeOrder {
    const char* A; const char* Bt; const LAS int* tab; int G, c; size_t bExpStride;
    __device__ __forceinline__ bool next(int i, Unit& u) const {
        const int ntile = __builtin_amdgcn_readfirstlane(tab[32]); const int nwg = ntile * NPN;
        const long L = (long)i * G + c; if (L >= nwg) return false;
        int wgid = (int)L; { const int q = nwg / NXCD, r = nwg % NXCD, xcd = wgid % NXCD, off = wgid / NXCD; wgid = (xcd < r ? xcd * (q + 1) : r * (q + 1) + (xcd - r) * q) + off; }
        const int mt = wgid / NPN, pn = wgid % NPN;
        const int e = __builtin_amdgcn_readfirstlane(tab[128 + mt]);
        const int ml = mt - __builtin_amdgcn_readfirstlane(tab[e]); const int cnt = __builtin_amdgcn_readfirstlane(tab[64 + e]);
        u.row0 = mt * BM; u.col0 = pn * COLSTEP; u.gbase = e * LIST_CAP + ml * BM; u.nvalid = (cnt - ml * BM) < BM ? (cnt - ml * BM) : BM;
        u.aBase = GATHER_A ? A : A + (size_t)mt * BM * KB;
        u.bBase = Bt + (size_t)e * bExpStride + (size_t)pn * BM * KB;
        return true;
    }
};

template <int KB  , bool FP8  , bool GATHER, class Epi, class Sched>
__device__ __forceinline__ void gemm_phase(LAS unsigned char* lds, const Sched& S, const Epi& E, const int* glist) {
    const int tid = threadIdx.x, wid = __builtin_amdgcn_readfirstlane(tid >> 6), lane = tid & 63, wr = wid >> 2, wc = wid & 3, fr = lane & 15, fq = lane >> 4;
    constexpr int nt = KB / 128; static_assert(!GATHER || FP8, "the gathered-A form exists for the rolled (fp8) K-loop only");
    unsigned voffA[2][2], nvoffA[2][2], voffB[2]; int RA[2], CA[2];
#pragma unroll
    for (int i = 0; i < 2; ++i) { int R, C; stage_rc(tid * 16 + i * 8192, R, C); const int Rb = Epi::PERM ? ((R & ~31) + perm32(R & 31)) : R; RA[i] = R; CA[i] = C;
        voffB[i] = (unsigned)(Rb * KB + C * 2);
#pragma unroll
        for (int h = 0; h < 2; ++h) { voffA[h][i] = (unsigned)((h * HALF + R) * KB + C * 2); nvoffA[h][i] = voffA[h][i]; } }
    constexpr size_t kstep = (size_t)(BK * 2);
    constexpr size_t hstep = (size_t)HALF * KB;
    const unsigned ldsw = (unsigned)wid * 1024u;
    const int aoff = lds_byte(wr * 64 + fr, fq * 8), boff = lds_byte(wc * 32 + fr, fq * 8);
#define PG8_SA(b, h) (((b) * 2 + (h)) * HTB)
#define PG8_SB(b, h) ((4 + (b) * 2 + (h)) * HTB)
#define PG8_STAGE_B(bufoff, gbase) do { _Pragma("unroll") for (int _i = 0; _i < 2; ++_i) \
        __builtin_amdgcn_global_load_lds((const unsigned*)((const char*)(gbase) + voffB[_i]), (LAS unsigned*)(lds + (bufoff) + ldsw + _i * 8192), 16, 0, 0); } while (0)
#define PG8_STAGE_A(bufoff, gbase, h, OFF) do { _Pragma("unroll") for (int _i = 0; _i < 2; ++_i) \
        __builtin_amdgcn_global_load_lds((const unsigned*)((const char*)(gbase) + OFF[h][_i]), (LAS unsigned*)(lds + (bufoff) + ldsw + _i * 8192), 16, 0, 0); } while (0)
#define PG8_LD8(p) __builtin_shufflevector(*(const LAS v4i*)(p), *(const LAS v4i*)((p) + 1024), 0, 1, 2, 3, 4, 5, 6, 7)
#define PG8_LDA(dst, b, h, xo) do { _Pragma("unroll") for (int m = 0; m < 4; ++m) dst[m] = PG8_LD8(lds + (xo) + PG8_SA(b, h) + aoff + m * 2048); } while (0)
#define PG8_LDB(dst, b, h, xo) do { _Pragma("unroll") for (int n = 0; n < 2; ++n) dst[n] = PG8_LD8(lds + (xo) + PG8_SB(b, h) + boff + n * 2048); } while (0)
#define PG8_LO(x) __builtin_bit_cast(bf16x8, __builtin_shufflevector(x, x, 0, 1, 2, 3))
#define PG8_HI(x) __builtin_bit_cast(bf16x8, __builtin_shufflevector(x, x, 4, 5, 6, 7))
#define PG8_MMA(ai, bj, At, Bt) do { __builtin_amdgcn_s_setprio(1); if constexpr (FP8) { _Pragma("unroll") for (int m = 0; m < 4; ++m) _Pragma("unroll") for (int n = 0; n < 2; ++n) \
        acc[ai][bj][m][n] = __builtin_amdgcn_mfma_scale_f32_16x16x128_f8f6f4(Bt[n], At[m], acc[ai][bj][m][n], 0, 0, 0, 0, 0, 0); } \
      else { _Pragma("unroll") for (int m = 0; m < 4; ++m) _Pragma("unroll") for (int n = 0; n < 2; ++n) { \
        acc[ai][bj][m][n] = __builtin_amdgcn_mfma_f32_16x16x32_bf16(PG8_LO(Bt[n]), PG8_LO(At[m]), acc[ai][bj][m][n], 0, 0, 0); \
        acc[ai][bj][m][n] = __builtin_amdgcn_mfma_f32_16x16x32_bf16(PG8_HI(Bt[n]), PG8_HI(At[m]), acc[ai][bj][m][n], 0, 0, 0); } } __builtin_amdgcn_s_setprio(0); } while (0)
#define PG8_WAIT_V(n) asm volatile("s_waitcnt vmcnt(" #n ")" ::: "memory")
#define PG8_WAIT_L(n) asm volatile("s_waitcnt lgkmcnt(" #n ")" ::: "memory")
#define PG8_BAR __builtin_amdgcn_s_barrier()
#define PG8_SCHED __builtin_amdgcn_sched_barrier(0)
#define PG8_GATHER_IDX(U, IDX) do { _Pragma("unroll") for (int _h = 0; _h < 2; ++_h) _Pragma("unroll") for (int _i = 0; _i < 2; ++_i) { int _r = _h * HALF + RA[_i]; \
        _r = _r < (U).nvalid ? _r : (U).nvalid - 1; IDX[_h][_i] = glist[(U).gbase + _r]; } } while (0)
#define PG8_IDX2OFF(IDX, OFF) do { _Pragma("unroll") for (int _h = 0; _h < 2; ++_h) _Pragma("unroll") for (int _i = 0; _i < 2; ++_i) \
        OFF[_h][_i] = (unsigned)IDX[_h][_i] * (unsigned)KB + (unsigned)(CA[_i] * 2); } while (0)
    Unit cur, nxt; int ui = 0;
    if (!S.next(0, cur)) return;
    f32x4 acc[2][2][4][2];
#pragma unroll
    for (int a = 0; a < 2; ++a)
#pragma unroll
        for (int b = 0; b < 2; ++b)
#pragma unroll
            for (int m = 0; m < 4; ++m)
#pragma unroll
                for (int n = 0; n < 2; ++n) acc[a][b][m][n] = (f32x4){0.f, 0.f, 0.f, 0.f};
    v8i At[4], B0[2], B1[2];
    const char* cA = cur.aBase; const char* cB = cur.bBase;
    int nidx[2][2] = {{0, 0}, {0, 0}};
    if constexpr (GATHER) { PG8_GATHER_IDX(cur, nidx); PG8_IDX2OFF(nidx, voffA); }
    PG8_STAGE_B(PG8_SB(0, 0), cB); PG8_STAGE_B(PG8_SB(0, 1), cB + hstep); PG8_STAGE_A(PG8_SA(0, 0), cA, 0, voffA); PG8_STAGE_A(PG8_SA(0, 1), cA, 1, voffA);
    if (wr == 1) PG8_BAR;
    PG8_WAIT_V(2); PG8_BAR;
    PG8_STAGE_B(PG8_SB(1, 0), cB + kstep); PG8_STAGE_A(PG8_SA(1, 0), cA + kstep, 0, voffA); PG8_STAGE_B(PG8_SB(1, 1), cB + hstep + kstep);
    PG8_WAIT_V(6); PG8_BAR;
    for (;;) {
        const bool has_next = S.next(ui + 1, nxt);
        const char* nA = has_next ? nxt.aBase : cA; const char* nB = has_next ? nxt.bBase : cB;
        if constexpr (GATHER) { if (has_next) { PG8_GATHER_IDX(nxt, nidx); } }
        if constexpr (FP8 || ROLL_ALL) {
#pragma unroll 1
        for (int t = 0; t < nt; ++t) {
            const int bo = (t & 1) * 2 * HTB, no = 2 * HTB - bo;
            const bool l1 = (t + 1 >= nt), l2 = (t + 2 >= nt);
            const char* a1 = l1 ? nA + (size_t)(t + 1 - nt) * kstep : cA + (size_t)(t + 1) * kstep;
            const char* a2 = l2 ? nA + (size_t)(t + 2 - nt) * kstep : cA + (size_t)(t + 2) * kstep;
            const char* b2 = l2 ? nB + (size_t)(t + 2 - nt) * kstep : cB + (size_t)(t + 2) * kstep;
            unsigned o1[2][2], o2[2][2];
#pragma unroll
            for (int h = 0; h < 2; ++h)
#pragma unroll
                for (int i = 0; i < 2; ++i) { o1[h][i] = voffA[h][i]; o2[h][i] = voffA[h][i]; }
            if (GATHER && l2) {
                if (has_next) { asm volatile("" : "+v"(nidx[0][0]), "+v"(nidx[0][1]), "+v"(nidx[1][0]), "+v"(nidx[1][1]));
                    PG8_IDX2OFF(nidx, nvoffA); }
#pragma unroll
                for (int h = 0; h < 2; ++h)
#pragma unroll
                    for (int i = 0; i < 2; ++i) { o2[h][i] = nvoffA[h][i]; if (l1) o1[h][i] = nvoffA[h][i]; } }
            PG8_LDB(B0, 0, 0, bo); PG8_LDB(B1, 0, 1, bo); PG8_SCHED; PG8_LDA(At, 0, 0, bo); PG8_STAGE_A(no + PG8_SA(0, 1), a1, 1, o1);
            PG8_WAIT_V(8); PG8_WAIT_L(0); PG8_BAR; PG8_MMA(0, 0, At, B0); PG8_MMA(0, 1, At, B1); PG8_BAR; PG8_SCHED;
            PG8_LDA(At, 0, 1, bo); PG8_STAGE_B(bo + PG8_SB(0, 0), b2); PG8_STAGE_B(bo + PG8_SB(0, 1), b2 + hstep); PG8_STAGE_A(bo + PG8_SA(0, 0), a2, 0, o2);
            PG8_WAIT_V(8); PG8_WAIT_L(0); PG8_BAR; PG8_MMA(1, 0, At, B0); PG8_MMA(1, 1, At, B1); PG8_BAR; PG8_SCHED;
        }
        } else {
#pragma unroll 1
        for (int t = 0; t < nt; t += 2) {
            const bool last = (t == nt - 2);
            const char* a1 = cA + (size_t)(t + 1) * kstep;
            const char* a2 = last ? nA : cA + (size_t)(t + 2) * kstep; const char* b2 = last ? nB : cB + (size_t)(t + 2) * kstep;
            const char* a3 = a2 + kstep; const char* b3 = b2 + kstep;
            unsigned oa[2][2];
#pragma unroll
            for (int h = 0; h < 2; ++h)
#pragma unroll
                for (int i = 0; i < 2; ++i) oa[h][i] = (GATHER && last) ? nvoffA[h][i] : voffA[h][i];
            PG8_LDB(B0, 0, 0, 0); PG8_LDB(B1, 0, 1, 0); PG8_SCHED; PG8_LDA(At, 0, 0, 0); PG8_STAGE_A(PG8_SA(1, 1), a1, 1, voffA);
            PG8_WAIT_V(8); PG8_WAIT_L(0); PG8_BAR; PG8_MMA(0, 0, At, B0); PG8_MMA(0, 1, At, B1); PG8_BAR; PG8_SCHED;
            PG8_LDA(At, 0, 1, 0); PG8_STAGE_B(PG8_SB(0, 0), b2); PG8_STAGE_B(PG8_SB(0, 1), b2 + hstep); PG8_STAGE_A(PG8_SA(0, 0), a2, 0, oa);
            PG8_WAIT_V(8); PG8_WAIT_L(0); PG8_BAR; PG8_MMA(1, 0, At, B0); PG8_MMA(1, 1, At, B1); PG8_BAR; PG8_SCHED;
            PG8_LDB(B0, 1, 0, 0); PG8_LDB(B1, 1, 1, 0); PG8_SCHED; PG8_LDA(At, 1, 0, 0); PG8_STAGE_A(PG8_SA(0, 1), a2, 1, oa);
            PG8_WAIT_V(8); PG8_WAIT_L(0); PG8_BAR; PG8_MMA(0, 0, At, B0); PG8_MMA(0, 1, At, B1); PG8_BAR; PG8_SCHED;
            PG8_LDA(At, 1, 1, 0); PG8_STAGE_B(PG8_SB(1, 0), b3); PG8_STAGE_B(PG8_SB(1, 1), b3 + hstep); PG8_STAGE_A(PG8_SA(1, 0), a3, 0, oa);
            PG8_WAIT_V(8); PG8_WAIT_L(0); PG8_BAR; PG8_MMA(1, 0, At, B0); PG8_MMA(1, 1, At, B1); PG8_BAR; PG8_SCHED;
        }
        }
        if (wr == 0) PG8_BAR;
        { int tz = threadIdx.x; asm volatile("" : "+v"(tz));
          E(acc, cur, wr, wc, tz & 15, (tz & 63) >> 4); }
        if (!has_next) break;
#pragma unroll
        for (int a = 0; a < 2; ++a)
#pragma unroll
            for (int b = 0; b < 2; ++b)
#pragma unroll
                for (int m = 0; m < 4; ++m)
#pragma unroll
                    for (int n = 0; n < 2; ++n) acc[a][b][m][n] = (f32x4){0.f, 0.f, 0.f, 0.f};
        cur = nxt; cA = nA; cB = nB; ++ui;
        if constexpr (GATHER) {
#pragma unroll
            for (int h = 0; h < 2; ++h)
#pragma unroll
                for (int i = 0; i < 2; ++i) voffA[h][i] = nvoffA[h][i]; }
        if (wr == 1) PG8_BAR;
    }
    PG8_WAIT_V(0);
    PG8_BAR;
#undef PG8_SA
#undef PG8_SB
#undef PG8_STAGE_A
#undef PG8_STAGE_B
#undef PG8_LDA
#undef PG8_LDB
#undef PG8_MMA
#undef PG8_LD8
#undef PG8_LO
#undef PG8_HI
#undef PG8_WAIT_V
#undef PG8_WAIT_L
#undef PG8_BAR
#undef PG8_SCHED
#undef PG8_GATHER_IDX
#undef PG8_IDX2OFF
}

struct EpiBf16 {
    static constexpr bool PERM = true;
    bf16* O; int ldc;
    __device__ __forceinline__ void operator()(const f32x4 (&acc)[2][2][4][2], const Unit& u, int wr, int wc, int fr, int fq) const {
        const int row0 = u.row0 + wr * 64 + fr, col0 = u.col0 + wc * 32 + 8 * fq;
#pragma unroll
        for (int ai = 0; ai < 2; ++ai)
#pragma unroll
            for (int m = 0; m < 4; ++m) { bf16* rowp = O + (size_t)(row0 + ai * HALF + m * 16) * ldc + col0;
#pragma unroll
                for (int bj = 0; bj < 2; ++bj) { const f32x4 v0 = acc[ai][bj][m][0], v1 = acc[ai][bj][m][1];
                    v4u w; w.x = cvt_pk_bf16(v0[0], v0[1]); w.y = cvt_pk_bf16(v0[2], v0[3]); w.z = cvt_pk_bf16(v1[0], v1[1]); w.w = cvt_pk_bf16(v1[2], v1[3]);
                    *(v4u*)(rowp + bj * HALF) = w; } }
    }
};
struct EpiResid {
    static constexpr bool PERM = true;
    const float* x; bf16* out; const float* gate;
    float* rowss;
    __device__ __forceinline__ void operator()(const f32x4 (&acc)[2][2][4][2], const Unit& u, int wr, int wc, int fr, int fq) const {
        const int row0 = u.row0 + wr * 64 + fr, col0 = u.col0 + wc * 32 + 8 * fq; const int b = u.row0 / SEQ;
        f32x4 gv[2][2];
#pragma unroll
        for (int bj = 0; bj < 2; ++bj)
#pragma unroll
            for (int n = 0; n < 2; ++n) gv[bj][n] = *(const f32x4*)(gate + (size_t)b * 6 * DM + col0 + bj * HALF + n * 4);
#pragma unroll
        for (int am = 0; am < 4; ++am) {
            const int ai = am >> 1, m0 = (am & 1) * 2;
            f32x4 xv[2][2][2];
#pragma unroll
            for (int mm = 0; mm < 2; ++mm) { const size_t off = (size_t)(row0 + ai * HALF + (m0 + mm) * 16) * DM + col0;
#pragma unroll
                for (int bj = 0; bj < 2; ++bj)
#pragma unroll
                    for (int n = 0; n < 2; ++n) xv[mm][bj][n] = *(const f32x4*)(x + off + bj * HALF + n * 4); }
#pragma unroll
            for (int mm = 0; mm < 2; ++mm) { const int m = m0 + mm; const size_t off = (size_t)(row0 + ai * HALF + m * 16) * DM + col0;
                float ss = 0.f;
#pragma unroll
                for (int bj = 0; bj < 2; ++bj) { const f32x4 o0 = xv[mm][bj][0] + gv[bj][0] * acc[ai][bj][m][0], o1 = xv[mm][bj][1] + gv[bj][1] * acc[ai][bj][m][1];
                    v4u w; w.x = cvt_pk_bf16(o0[0], o0[1]); w.y = cvt_pk_bf16(o0[2], o0[3]); w.z = cvt_pk_bf16(o1[0], o1[1]); w.w = cvt_pk_bf16(o1[2], o1[3]);
                    *(v4u*)(out + off + bj * HALF) = w;
#pragma unroll
                    for (int q = 0; q < 4; ++q) { const float lo = bflo(w[q]), hi = bfhi(w[q]); ss += lo * lo + hi * hi; } }
                ss += __shfl_xor(ss, 16); ss += __shfl_xor(ss, 32);
                if (fq == 0) rowss[(size_t)(row0 + ai * HALF + m * 16) * 32 + (u.col0 >> 8) * 4 + wc] = ss; }
            asm volatile("" ::: "memory"); }
    }
};
struct EpiSwiglu {
    static constexpr bool PERM = true;
    unsigned char* O;
    __device__ __forceinline__ void operator()(const f32x4 (&acc)[2][2][4][2], const Unit& u, int wr, int wc, int fr, int fq) const {
        const int row0 = u.row0 + wr * 64 + fr, col0 = u.col0 + wc * 32 + 8 * fq; constexpr float isc = 1.0f / (F8S_H2 * F8S_W);
#pragma unroll
        for (int ai = 0; ai < 2; ++ai)
#pragma unroll
            for (int m = 0; m < 4; ++m) { unsigned char* rowp = O + (size_t)(row0 + ai * HALF + m * 16) * FF + col0; float o[8];
#pragma unroll
                for (int n = 0; n < 2; ++n)
#pragma unroll
                    for (int j = 0; j < 4; ++j) { const float a = acc[ai][0][m][n][j] * isc, g = acc[ai][1][m][n][j] * (isc * F8S_HID); o[n * 4 + j] = a * fast_sigmoid(a) * g; }
                v2u w; w.x = pack4_fp8(o[0], o[1], o[2], o[3]); w.y = pack4_fp8(o[4], o[5], o[6], o[7]);
                *(v2u*)rowp = w; }
    }
};
struct EpiDown {
    static constexpr bool PERM = true;
    unsigned char* O;
    __device__ __forceinline__ void operator()(const f32x4 (&acc)[2][2][4][2], const Unit& u, int wr, int wc, int fr, int fq) const {
        const int rl0 = wr * 64 + fr, col0 = u.col0 + wc * 32 + 8 * fq; constexpr float gt = F8S_Y / (F8S_HID * F8S_W);
#pragma unroll
        for (int ai = 0; ai < 2; ++ai)
#pragma unroll
            for (int m = 0; m < 4; ++m) { const int rl = rl0 + ai * HALF + m * 16;
                unsigned char* rowp = O + (size_t)(u.row0 + rl) * DM + col0;
#pragma unroll
                for (int bj = 0; bj < 2; ++bj) { const f32x4 v0 = acc[ai][bj][m][0] * gt, v1 = acc[ai][bj][m][1] * gt;
                    v2u w; w.x = pack4_fp8(v0[0], v0[1], v0[2], v0[3]); w.y = pack4_fp8(v1[0], v1[1], v1[2], v1[3]);
                    *(v2u*)(rowp + bj * HALF) = w; } }
    }
};
}

struct Frame {
    LAS unsigned char* lds;
    int tid, lane, wave, vcu, G;
    unsigned char* ws;
    const float *x, *c, *w_ada, *b_ada, *g_mix, *w_in, *lru_conv_w, *lru_conv_b, *lru_w_a, *lru_b_a, *lru_w_x, *lru_b_x, *lru_lambda, *lru_out_g,
                *sc_conv_w, *sc_out_g, *w_out, *g_ffn, *w_rg, *b_rg, *w_re, *b_re, *w1, *w3, *w2, *g_final;
    float* out;
};

__device__ __forceinline__ void phase0(const Frame& F) {
    LAS float* cond = (LAS float*)F.lds;
    LAS float* red = (LAS float*)(F.lds + 32768);
    for (int i = F.tid; i < NB * DM; i += 512) { const float v = F.c[i]; cond[i] = v / (1.0f + __expf(-v)); }
    __syncthreads();
    {
        bf16* wf = (bf16*)(F.ws + WS_WRT);
        for (int i = F.vcu * 512 + F.tid; i < 48 * DM; i += F.G * 512) { const int e = i / DM, k = i % DM;
            const float v = e < 32 ? F.w_re[k * 32 + e] : (e < 36 ? F.w_rg[k * 4 + (e - 32)] : 0.f);
            const unsigned h = f2bf(v); const int t = k >> 5, fq = (k >> 3) & 3, jj = k & 7, n = e >> 4, fr = e & 15;
            const size_t o = ((size_t)((t * 3 + n) * 2) * 64 + fq * 16 + fr) * 8 + jj;
            wf[o] = (bf16)h; wf[o + 512] = (bf16)f2bf(v - bf2f(h)); }
    }
    {
        bf16* wl = (bf16*)(F.ws + WS_WLRU);
        for (int i = F.vcu * 512 + F.tid; i < 4 * 2 * 256 * 256; i += F.G * 512) { const int head = i >> 17, g = (i >> 16) & 1, k = (i >> 8) & 255, j = i & 255;
            const float v = (g ? F.lru_w_x : F.lru_w_a)[(size_t)head * 65536 + k * 256 + j];
            wl[(size_t)((head * 2 + g) * 256 + j) * 256 + k] = (bf16)f2bf(v); }
    }
    {
        LAS float* scr = (LAS float*)(F.lds + 65536 + F.wave * 8704);
        const int gw = F.vcu * 8 + F.wave, NGW = F.G * 8;
        constexpr int I_IN = 32 * 160, I_OUT = 32 * 64, I_13 = NEXP * 32 * 64, I_2 = NEXP * 16 * 64;
        constexpr int NITEMS = I_IN + I_OUT + I_13 + I_2;
        struct TItem { const float* src; unsigned char* dst; int ldw, K, n0d, fp8; };
        auto decode = [&](int it) -> TItem {
            TItem t; int r = it;
            if (r < I_IN) { const int kb = r / 160, nb = r % 160; t.src = F.w_in + (size_t)(kb * 64) * IN_COLS + nb * 32; t.ldw = IN_COLS;
                int nd = nb * 32;
                if (nd >= 2048) { const int tq = (nd - 2048) >> 10, ch = (nd - 2048) & 1023; nd = 2048 + (ch >> 7) * 384 + tq * 128 + (ch & 127); }
                t.dst = F.ws + WS_WIN + ((size_t)nd * DM + kb * 64) * 2; t.K = DM; t.fp8 = 0; return t; } r -= I_IN;
            if (r < I_OUT) { const int kb = r / 64, nb = r % 64; t.src = F.w_out + (size_t)(kb * 64) * DM + nb * 32; t.ldw = DM; t.dst = F.ws + WS_WOUT + ((size_t)(nb * 32) * DM + kb * 64) * 2; t.K = DM; t.fp8 = 0; return t; } r -= I_OUT;
            if (r < I_13) { const int e = r / 2048, q = r % 2048, kb = q / 64, nb = q % 64;
                const int pn = nb >> 3, half = (nb >> 2) & 1, j0 = (nb & 3) * 32;
                t.src = (half ? F.w3 : F.w1) + (size_t)e * DM * FF + (size_t)(kb * 64) * FF + pn * 128 + j0; t.ldw = FF;
                t.dst = F.ws + WS_W13 + (size_t)e * DM * DM + (size_t)(nb * 32) * DM + kb * 64; t.K = DM; t.fp8 = 1; return t; } r -= I_13;
            { const int e = r / 1024, q = r % 1024, kb = q / 64, nb = q % 64;
                t.src = F.w2 + (size_t)e * FF * DM + (size_t)(kb * 64) * DM + nb * 32; t.ldw = DM; t.dst = F.ws + WS_W2 + (size_t)e * DM * FF + (size_t)(nb * 32) * FF + kb * 64; t.K = FF; t.fp8 = 1; return t; }
        };
        const int cq = F.tid % 12, kg = F.tid / 12; const bool modt = (kg < 42) && (F.vcu < 256);
        const float* wada = F.w_ada + (size_t)(F.vcu < 256 ? F.vcu : 0) * 48 + 4 * cq;
        f32x4 a0 = {0, 0, 0, 0}, a1 = a0, a2 = a0, a3 = a0, wcur = a0, wnext = a0; int kpos = kg;
        if (modt) wcur = *(const f32x4*)(wada + (size_t)kpos * (6 * DM));
        f32x4 cur[8], nxt[8];
        int it = gw; TItem ti{};
        if (it < NITEMS) { ti = decode(it);
#pragma unroll
            for (int i = 0; i < 8; ++i) cur[i] = __builtin_nontemporal_load((const f32x4*)(ti.src + (size_t)(8 * i + (F.lane >> 3)) * ti.ldw + 4 * (F.lane & 7))); }
        for (; it < NITEMS; it += NGW) {
            const int itn = it + NGW; TItem tn = ti;
            const bool mnext = modt && (kpos + 42 < DM);
            if (mnext) wnext = *(const f32x4*)(wada + (size_t)(kpos + 42) * (6 * DM));
            if (itn < NITEMS) { tn = decode(itn);
#pragma unroll
                for (int i = 0; i < 8; ++i) nxt[i] = __builtin_nontemporal_load((const f32x4*)(tn.src + (size_t)(8 * i + (F.lane >> 3)) * tn.ldw + 4 * (F.lane & 7))); }
#pragma unroll
            for (int i = 0; i < 8; ++i) { LAS float* sw = scr + (8 * i + (F.lane >> 3)) * 33 + 4 * (F.lane & 7); sw[0] = cur[i].x; sw[1] = cur[i].y; sw[2] = cur[i].z; sw[3] = cur[i].w; }
            LDS_WAIT(); asm volatile("" ::: "memory");
            if (ti.fp8) { const int c = F.lane & 3;
#pragma unroll
                for (int j = 0; j < 2; ++j) { const int n = (F.lane >> 2) + 16 * j; const LAS float* sp = scr + (16 * c) * 33 + n; v4u o;
#pragma unroll
                    for (int q = 0; q < 4; ++q) o[q] = pack4_fp8(sp[(4 * q) * 33] * F8S_W, sp[(4 * q + 1) * 33] * F8S_W, sp[(4 * q + 2) * 33] * F8S_W, sp[(4 * q + 3) * 33] * F8S_W);
                    __builtin_nontemporal_store(o, (v4u*)(ti.dst + (size_t)n * ti.K + 16 * c)); }
            } else { const int c = F.lane & 7;
#pragma unroll
                for (int j = 0; j < 4; ++j) { const int n = (F.lane >> 3) + 8 * j; const LAS float* sp = scr + (8 * c) * 33 + n;
                    v4u o; o.x = pk2(sp[0 * 33], sp[1 * 33]); o.y = pk2(sp[2 * 33], sp[3 * 33]); o.z = pk2(sp[4 * 33], sp[5 * 33]); o.w = pk2(sp[6 * 33], sp[7 * 33]);
                    *(v4u*)(ti.dst + ((size_t)n * ti.K + 8 * c) * 2) = o; } }
            LDS_WAIT(); asm volatile("" ::: "memory");
            ti = tn;
#pragma unroll
            for (int i = 0; i < 8; ++i) cur[i] = nxt[i];
            if (modt && kpos < DM) { a0 += wcur * cond[kpos]; a1 += wcur * cond[DM + kpos]; a2 += wcur * cond[2 * DM + kpos]; a3 += wcur * cond[3 * DM + kpos]; kpos += 42; wcur = wnext; }
        }
        if (modt) { for (; kpos < DM; kpos += 42) { const f32x4 w = *(const f32x4*)(wada + (size_t)kpos * (6 * DM));
                a0 += w * cond[kpos]; a1 += w * cond[DM + kpos]; a2 += w * cond[2 * DM + kpos]; a3 += w * cond[3 * DM + kpos]; }
            LAS float* r = red + kg * 192 + cq * 4;
#pragma unroll
            for (int j = 0; j < 4; ++j) { r[j] = a0[j]; r[48 + j] = a1[j]; r[96 + j] = a2[j]; r[144 + j] = a3[j]; } }
        __syncthreads();
        if (F.tid < 192 && F.vcu < 256) { float sm = 0.f; for (int g = 0; g < 42; ++g) sm += red[g * 192 + F.tid]; const int bb = F.tid / 48, cc = F.tid % 48;
            ((float*)(F.ws + WS_MOD))[bb * 6 * DM + F.vcu * 48 + cc] = sm + F.b_ada[F.vcu * 48 + cc]; }
        for (int chunk = F.vcu + F.G; chunk < 256; chunk += F.G) {
            __syncthreads();
            const int col0 = chunk * 48; f32x4 b0 = {0, 0, 0, 0}, b1 = b0, b2 = b0, b3 = b0;
            if (kg < 42) { for (int k = kg; k < DM; k += 42) { const f32x4 w = *(const f32x4*)(F.w_ada + (size_t)k * (6 * DM) + col0 + 4 * cq);
                    b0 += w * cond[k]; b1 += w * cond[DM + k]; b2 += w * cond[2 * DM + k]; b3 += w * cond[3 * DM + k]; }
                LAS float* r = red + kg * 192 + cq * 4;
#pragma unroll
                for (int j = 0; j < 4; ++j) { r[j] = b0[j]; r[48 + j] = b1[j]; r[96 + j] = b2[j]; r[144 + j] = b3[j]; } }
            __syncthreads();
            if (F.tid < 192) { float sm = 0.f; for (int g = 0; g < 42; ++g) sm += red[g * 192 + F.tid]; const int bb = F.tid / 48, cc = F.tid % 48;
                ((float*)(F.ws + WS_MOD))[bb * 6 * DM + col0 + cc] = sm + F.b_ada[col0 + cc]; }
        }
    }
}

__device__ __forceinline__ void norm_rows(const Frame& F, const float* xin, const float* gain, const float* mod_sh, const float* mod_sc, bf16* outp, int row_begin, int nrows, LAS float* rstd_lds, bool want_rstd) {
    const int b = row_begin / SEQ;
    f32x4 gs[8], sh[8];
#pragma unroll
    for (int j = 0; j < 8; ++j) { const int c = 4 * F.lane + 256 * j; const f32x4 g = *(const f32x4*)(gain + c), s = *(const f32x4*)(mod_sc + (size_t)b * 6 * DM + c);
        gs[j] = g * (s + 1.0f); sh[j] = *(const f32x4*)(mod_sh + (size_t)b * 6 * DM + c); }
    f32x4 va[8], vb[8], na[8], nb_[8];
    { const f32x4* x0 = (const f32x4*)(xin + (size_t)row_begin * DM) + F.lane; const f32x4* x1p = x0 + DM / 4;
#pragma unroll
      for (int j = 0; j < 8; ++j) { va[j] = __builtin_nontemporal_load(x0 + 64 * j); vb[j] = __builtin_nontemporal_load(x1p + 64 * j); } }
#pragma unroll 1
    for (int r = 0; r < nrows; r += 2) {
        const int row = row_begin + r; const int rn = (r + 2 < nrows) ? row + 2 : row;
        { const f32x4* x0 = (const f32x4*)(xin + (size_t)rn * DM) + F.lane; const f32x4* x1p = x0 + DM / 4;
#pragma unroll
          for (int j = 0; j < 8; ++j) { na[j] = __builtin_nontemporal_load(x0 + 64 * j); nb_[j] = __builtin_nontemporal_load(x1p + 64 * j); } }
        float s0 = 0.f, s1 = 0.f;
#pragma unroll
        for (int j = 0; j < 8; ++j) { s0 += (va[j].x * va[j].x + va[j].y * va[j].y) + (va[j].z * va[j].z + va[j].w * va[j].w); s1 += (vb[j].x * vb[j].x + vb[j].y * vb[j].y) + (vb[j].z * vb[j].z + vb[j].w * vb[j].w); }
        const float rstd0 = 1.0f / sqrtf(wave_sum(s0) * (1.0f / DM) + EPS), rstd1 = 1.0f / sqrtf(wave_sum(s1) * (1.0f / DM) + EPS);
        if (want_rstd && F.lane == 0) { rstd_lds[r] = rstd0; rstd_lds[r + 1] = rstd1; }
        v2u* o8 = (v2u*)(outp + (size_t)row * DM) + F.lane;
#pragma unroll
        for (int j = 0; j < 8; ++j) { const f32x4 h0 = va[j] * rstd0 * gs[j] + sh[j], h1 = vb[j] * rstd1 * gs[j] + sh[j]; v2u w0, w1; w0.x = pk2(h0.x, h0.y); w0.y = pk2(h0.z, h0.w); w1.x = pk2(h1.x, h1.y); w1.y = pk2(h1.z, h1.w);
            o8[64 * j] = w0; o8[DM / 4 + 64 * j] = w1; }
#pragma unroll
        for (int j = 0; j < 8; ++j) { va[j] = na[j]; vb[j] = nb_[j]; }
    }
}

__device__ __forceinline__ void sconv_phase(const Frame& F, int first_round) {
    const bf16* proj = (const bf16*)(F.ws + WS_PROJ); bf16* ycat = (bf16*)(F.ws + WS_YCAT);
    const int gw = F.vcu * 8 + F.wave, NGW = F.G * 8;
    const int cb = F.lane & 15, q = F.lane >> 4;
    for (int wu = gw + first_round * NGW; wu < 8 * 256; wu += NGW) {
        const int g = (wu & 1) * 4 + q, ck = wu >> 1; const int c0 = g * 128 + cb * 8;
        float w0[8], w1[8], w2[8], gn[8];
#pragma unroll
        for (int j = 0; j < 8; ++j) { w0[j] = F.sc_conv_w[c0 + j]; w1[j] = F.sc_conv_w[SC_W + c0 + j]; w2[j] = F.sc_conv_w[2 * SC_W + c0 + j]; gn[j] = F.sc_out_g[c0 + j]; }
        const int r_s = ck * 32; const int t_s = r_s % SEQ; const int pc0 = 2048 + g * 384 + cb * 8;
        float p1[8], p2[8];
#pragma unroll
        for (int j = 0; j < 8; ++j) { p1[j] = 0.f; p2[j] = 0.f; }
        if (t_s >= 1) { const v4u cv = *(const v4u*)(proj + (size_t)(r_s - 1) * IN_COLS + pc0 + 128), xv = *(const v4u*)(proj + (size_t)(r_s - 1) * IN_COLS + pc0 + 256);
#pragma unroll
            for (int j = 0; j < 4; ++j) { p1[2 * j] = bflo(cv[j]) * bflo(xv[j]); p1[2 * j + 1] = bfhi(cv[j]) * bfhi(xv[j]); } }
        if (t_s >= 2) { const v4u cv = *(const v4u*)(proj + (size_t)(r_s - 2) * IN_COLS + pc0 + 128), xv = *(const v4u*)(proj + (size_t)(r_s - 2) * IN_COLS + pc0 + 256);
#pragma unroll
            for (int j = 0; j < 4; ++j) { p2[2 * j] = bflo(cv[j]) * bflo(xv[j]); p2[2 * j + 1] = bfhi(cv[j]) * bfhi(xv[j]); } }
#pragma unroll 2
        for (int i = 0; i < 32; ++i) {
            const size_t ro = (size_t)(r_s + i) * IN_COLS + pc0;
            const v4u bv = *(const v4u*)(proj + ro), cv = *(const v4u*)(proj + ro + 128), xv = *(const v4u*)(proj + ro + 256);
            float y[8]; float ss = 0.f;
#pragma unroll
            for (int j = 0; j < 4; ++j) {
                const float pa = bflo(cv[j]) * bflo(xv[j]), pb = bfhi(cv[j]) * bfhi(xv[j]);
                y[2 * j] = bflo(bv[j]) * (w0[2 * j] * p2[2 * j] + w1[2 * j] * p1[2 * j] + w2[2 * j] * pa);
                y[2 * j + 1] = bfhi(bv[j]) * (w0[2 * j + 1] * p2[2 * j + 1] + w1[2 * j + 1] * p1[2 * j + 1] + w2[2 * j + 1] * pb);
                p2[2 * j] = p1[2 * j]; p2[2 * j + 1] = p1[2 * j + 1]; p1[2 * j] = pa; p1[2 * j + 1] = pb;
                ss += y[2 * j] * y[2 * j] + y[2 * j + 1] * y[2 * j + 1]; }
            ss += __shfl_xor(ss, 1); ss += __shfl_xor(ss, 2); ss += __shfl_xor(ss, 4); ss += __shfl_xor(ss, 8);
            const float rstd = 1.0f / sqrtf(ss * (1.0f / 128.0f) + EPS);
            v4u o;
#pragma unroll
            for (int j = 0; j < 4; ++j) o[j] = pk2(y[2 * j] * rstd * gn[2 * j], y[2 * j + 1] * rstd * gn[2 * j + 1]);
            *(v4u*)(ycat + (size_t)(r_s + i) * DM + 1024 + c0) = o;
        }
    }
}

constexpr int LRU_T = 128;
constexpr int LRU_XC = 0;
constexpr int LRU_G = 65536;
constexpr int LRU_PS = LRU_G + 128 * 528;
constexpr int LRU_HIN = LRU_PS + 4096;
constexpr int LRU_RS = LRU_HIN + 1024;
constexpr int LRU_HIN2 = LRU_RS + 512;
__device__ __forceinline__ int xc_off(int r, int c) { const int st = (r >> 4) * 8 + (c >> 5), ob = (r & 15) * 64 + (c & 31) * 2; return st * 1024 + (ob ^ (((ob >> 9) & 1) << 5)); }

template <bool FINAL>
__device__ __forceinline__ void lru_phase(const Frame& F) {
    const bf16* proj = (const bf16*)(F.ws + WS_PROJ); bf16* ycat = (bf16*)(F.ws + WS_YCAT); f32x2* car = (f32x2*)(F.ws + WS_CAR);
    v4u* au = (v4u*)(F.ws + WS_H);
    LAS unsigned char* lds = F.lds;
    bf16x8 Bw[2][2][8]; float ba[2] = {0.f, 0.f}, bx[2] = {0.f, 0.f}, cneg[2] = {0.f, 0.f}; int cur_head = -1;
#pragma unroll
    for (int g = 0; g < 2; ++g)
#pragma unroll
        for (int n = 0; n < 2; ++n)
#pragma unroll
            for (int kk = 0; kk < 8; ++kk) Bw[g][n][kk] = (bf16x8){0, 0, 0, 0, 0, 0, 0, 0};
#pragma unroll 1
    for (int u = F.vcu; u < 1024; u += F.G) {
        const int head = u & 3, bt = u >> 2, b = bt >> 6, tt = bt & 63;
        int tz = threadIdx.x; asm volatile("" : "+v"(tz));
        const int tid = tz, lane = tz & 63, fr = lane & 15, fq = lane >> 4;
        const int rowbase = b * SEQ + tt * LRU_T;
        if (FINAL) {
            const int half = tid >> 8, ch = tid & 255; const int n0 = (tt + 1) >> 1; const int kbeg = half ? n0 : 0, cnt = half ? (tt - n0) : n0;
            const f32x2* cp = car + (size_t)(b * 64) * LRU_W + head * LRU_HD + ch; f32x2 v[32];
#pragma unroll
            for (int q = 0; q < 32; ++q) { int k = kbeg + q; k = k > 63 ? 63 : k; v[q] = cp[(size_t)k * LRU_W]; }
            float A = 1.f, H = 0.f;
#pragma unroll
            for (int q = 0; q < 32; ++q) { const float a = q < cnt ? v[q].x : 1.f, hh = q < cnt ? v[q].y : 0.f; H = a * H + hh; A = a * A; }
            if (half == 0) ((LAS float*)(lds + LRU_HIN))[ch] = H; else { ((LAS float*)(lds + LRU_HIN2))[ch] = A; ((LAS float*)(lds + LRU_HIN2))[256 + ch] = H; }
        }
        {
            const int cb = tid & 31, rr = tid >> 5; const int c0 = head * LRU_HD + cb * 8;
            v4u xr[11];
#pragma unroll
            for (int q = 0; q < 11; ++q) { const int t = tt * LRU_T + rr * 8 - 3 + q;
                if (t >= 0) xr[q] = *(const v4u*)(proj + (size_t)(b * SEQ + t) * IN_COLS + c0); else xr[q] = (v4u){0u, 0u, 0u, 0u}; }
            float cw[4][8], cbias[8];
#pragma unroll
            for (int k = 0; k < 4; ++k)
#pragma unroll
                for (int j = 0; j < 8; ++j) cw[k][j] = F.lru_conv_w[k * LRU_W + c0 + j];
#pragma unroll
            for (int j = 0; j < 8; ++j) cbias[j] = F.lru_conv_b[c0 + j];
#pragma unroll
            for (int r = 0; r < 8; ++r) { float o[8];
#pragma unroll
                for (int j = 0; j < 4; ++j) { float lo = cbias[2 * j], hi = cbias[2 * j + 1];
#pragma unroll
                    for (int k = 0; k < 4; ++k) { lo += cw[k][2 * j] * bflo(xr[r + k][j]); hi += cw[k][2 * j + 1] * bfhi(xr[r + k][j]); }
                    o[2 * j] = lo; o[2 * j + 1] = hi; }
                v4u w; w.x = pk2(o[0], o[1]); w.y = pk2(o[2], o[3]); w.z = pk2(o[4], o[5]); w.w = pk2(o[6], o[7]);
                *(LAS v4u*)(lds + LRU_XC + xc_off(rr * 8 + r, cb * 8)) = w; }
        }
        if (FINAL) {
#pragma unroll
            for (int i = 0; i < 8; ++i) { const int p = tid + 512 * i, t = p >> 5, cp = p & 31;
                const v4u v = *(const v4u*)(proj + (size_t)(rowbase + t) * IN_COLS + 1024 + head * LRU_HD + cp * 8);
                *(LAS v4u*)(lds + LRU_G + t * 528 + cp * 16) = v; }
        }
        asm volatile("" ::: "memory"); __builtin_amdgcn_sched_barrier(0);
        if (head != cur_head) { cur_head = head; const bf16* wl = (const bf16*)(F.ws + WS_WLRU);
#pragma unroll
            for (int g = 0; g < 2; ++g)
#pragma unroll
                for (int n = 0; n < 2; ++n) { const bf16* wp = wl + (size_t)((head * 2 + g) * 256 + F.wave * 32 + n * 16 + fr) * 256 + 8 * fq;
#pragma unroll
                    for (int kk = 0; kk < 8; ++kk) Bw[g][n][kk] = *(const bf16x8*)(wp + kk * 32); }
#pragma unroll
            for (int n = 0; n < 2; ++n) { const int ch = head * LRU_HD + F.wave * 32 + n * 16 + fr; ba[n] = F.lru_b_a[ch]; bx[n] = F.lru_b_x[ch];
                cneg[n] = -8.0f * log1pf(expf(-F.lru_lambda[ch])) * 1.4426950408889634f; }
        }
        __syncthreads();
        float hc[2], At_[2], Ht_[2];
#pragma unroll
        for (int n = 0; n < 2; ++n) { { const int jj = F.wave * 32 + n * 16 + fr; hc[n] = FINAL ? ((LAS float*)(lds + LRU_HIN2))[jj] * ((LAS float*)(lds + LRU_HIN))[jj] + ((LAS float*)(lds + LRU_HIN2))[256 + jj] : 0.f; } At_[n] = 1.f; Ht_[n] = 0.f; }
#pragma unroll 1
        for (int m = 0; m < 8; ++m) {
            f32x4 acc[2][2];
#pragma unroll
            for (int g = 0; g < 2; ++g)
#pragma unroll
                for (int n = 0; n < 2; ++n) acc[g][n] = (f32x4){0.f, 0.f, 0.f, 0.f};
#pragma unroll
            for (int kk = 0; kk < 8; ++kk) { const bf16x8 a = *(const LAS bf16x8*)(lds + LRU_XC + xc_off(m * 16 + fr, kk * 32 + fq * 8));
#pragma unroll
                for (int g = 0; g < 2; ++g)
#pragma unroll
                    for (int n = 0; n < 2; ++n) acc[g][n] = __builtin_amdgcn_mfma_f32_16x16x32_bf16(a, Bw[g][n][kk], acc[g][n], 0, 0, 0); }
            float ssq[4] = {0.f, 0.f, 0.f, 0.f};
            __builtin_amdgcn_sched_barrier(0);
#pragma unroll
            for (int n = 0; n < 2; ++n) {
                if (n) __builtin_amdgcn_sched_barrier(0);
                const int j = F.wave * 32 + n * 16 + fr;
                float av[4], uv[4]; v4u aupk;
#pragma unroll
                for (int r = 0; r < 4; ++r) { const int t = m * 16 + 4 * fq + r;
                    const float rg = fast_sigmoid(acc[0][n][r] + ba[n]), ig = fast_sigmoid(acc[1][n][r] + bx[n]);
                    const float l2x = cneg[n] * rg;
                    const float a2 = __builtin_amdgcn_exp2f(2.0f * l2x);
                    const float mult = __builtin_amdgcn_sqrtf(1.0f - a2);
                    const float xcv = bf2f(*(const LAS unsigned short*)(lds + LRU_XC + xc_off(t, j)));
                    const unsigned l2b = f2bf(l2x), ub = f2bf(mult * (ig * xcv));
                    aupk[r] = l2b | (ub << 16);
                    av[r] = __builtin_amdgcn_exp2f(bf2f(l2b)); uv[r] = bf2f(ub); }
                if (!FINAL) au[((size_t)u * 16 + m * 2 + n) * 512 + F.wave * 64 + lane] = aupk;
                float P[4], Q[4]; P[0] = av[0]; Q[0] = uv[0];
#pragma unroll
                for (int r = 1; r < 4; ++r) { Q[r] = av[r] * Q[r - 1] + uv[r]; P[r] = av[r] * P[r - 1]; }
                float TP = P[3], TQ = Q[3];
                { const float pp = __shfl_up(TP, 16), pq = __shfl_up(TQ, 16); if (fq >= 1) { TQ = TP * pq + TQ; TP = TP * pp; } }
                { const float pp = __shfl_up(TP, 32), pq = __shfl_up(TQ, 32); if (fq >= 2) { TQ = TP * pq + TQ; TP = TP * pp; } }
                if (FINAL) {
                    float EP = __shfl_up(TP, 16), EQ = __shfl_up(TQ, 16); if (fq == 0) { EP = 1.f; EQ = 0.f; }
                    const float hin = EP * hc[n] + EQ;
                    const float hnew = TP * hc[n] + TQ;
                    hc[n] = __shfl(hnew, fr + 48);
#pragma unroll
                    for (int r = 0; r < 4; ++r) { const int t = m * 16 + 4 * fq + r; const float h = P[r] * hin + Q[r];
                        LAS unsigned short* gp = (LAS unsigned short*)(lds + LRU_G + t * 528 + j * 2);
                        const float gt = bf2f(*gp);
                        const float y = h * gt * fast_sigmoid(1.5957691216057308f * (gt + 0.044715f * gt * gt * gt));
                        ssq[r] += y * y; *gp = (unsigned short)f2bf(y); }
                } else {
                    const float tP = __shfl(TP, fr + 48), tQ = __shfl(TQ, fr + 48);
                    Ht_[n] = tP * Ht_[n] + tQ; At_[n] = tP * At_[n];
                }
            }
            if (FINAL) {
#pragma unroll
                for (int r = 0; r < 4; ++r) { float s = ssq[r]; s += __shfl_xor(s, 1); s += __shfl_xor(s, 2); s += __shfl_xor(s, 4); s += __shfl_xor(s, 8);
                    if (fr == 0) ((LAS float*)(lds + LRU_PS))[(m * 16 + 4 * fq + r) * 8 + F.wave] = s; }
            }
        }
        if (!FINAL) {
            if (fq == 3) {
#pragma unroll
                for (int n = 0; n < 2; ++n) car[(size_t)(b * 64 + tt) * LRU_W + head * LRU_HD + F.wave * 32 + n * 16 + fr] = (f32x2){At_[n], Ht_[n]};
            }
        } else {
            __syncthreads();
            if (tid < 128) { const LAS float* ps = (const LAS float*)(lds + LRU_PS) + tid * 8; float s = 0.f;
#pragma unroll
                for (int w = 0; w < 8; ++w) s += ps[w];
                ((LAS float*)(lds + LRU_RS))[tid] = 1.0f / sqrtf(s * (1.0f / LRU_HD) + EPS); }
            __syncthreads();
#pragma unroll
            for (int i = 0; i < 8; ++i) { const int p = tid + 512 * i, t = p >> 5, cp = p & 31;
                const v4u v = *(const LAS v4u*)(lds + LRU_G + t * 528 + cp * 16); const float rs = ((const LAS float*)(lds + LRU_RS))[t];
                const float* gp = F.lru_out_g + head * LRU_HD + cp * 8; v4u o;
#pragma unroll
                for (int jx = 0; jx < 4; ++jx) o[jx] = pk2(bflo(v[jx]) * rs * gp[2 * jx], bfhi(v[jx]) * rs * gp[2 * jx + 1]);
                *(v4u*)(ycat + (size_t)(rowbase + t) * DM + head * LRU_HD + cp * 8) = o; }
        }
        __syncthreads();
    }
}

__device__ __forceinline__ void lru_final_phase(const Frame& F) {
    const bf16* proj = (const bf16*)(F.ws + WS_PROJ); bf16* ycat = (bf16*)(F.ws + WS_YCAT); const f32x2* car = (const f32x2*)(F.ws + WS_CAR);
    const v4u* au = (const v4u*)(F.ws + WS_H);
    LAS unsigned char* lds = F.lds;
    const int sc_wu = F.vcu * 8 + F.wave; const bool sc_on = sc_wu < 8 * 256;
    const int sc_cb = F.lane & 15, sc_g = (sc_wu & 1) * 4 + (F.lane >> 4), sc_c0 = sc_g * 128 + sc_cb * 8, sc_rs = (sc_on ? (sc_wu >> 1) : 0) * 32, sc_pc0 = 2048 + sc_g * 384 + sc_cb * 8;
    float sw0[8], sw1[8], sw2[8], sgn[8], sp1[8], sp2[8]; v4u sbb, scc, sxx, snb, snc, snx; int sc_i = 0;
#pragma unroll
    for (int j = 0; j < 8; ++j) { sw0[j] = F.sc_conv_w[sc_c0 + j]; sw1[j] = F.sc_conv_w[SC_W + sc_c0 + j]; sw2[j] = F.sc_conv_w[2 * SC_W + sc_c0 + j]; sgn[j] = F.sc_out_g[sc_c0 + j]; sp1[j] = 0.f; sp2[j] = 0.f; }
    { const int t_s = sc_rs % SEQ; const int r1 = t_s >= 1 ? sc_rs - 1 : sc_rs, r2 = t_s >= 2 ? sc_rs - 2 : sc_rs;
      const v4u c1 = *(const v4u*)(proj + (size_t)r1 * IN_COLS + sc_pc0 + 128), x1v = *(const v4u*)(proj + (size_t)r1 * IN_COLS + sc_pc0 + 256);
      const v4u c2 = *(const v4u*)(proj + (size_t)r2 * IN_COLS + sc_pc0 + 128), x2v = *(const v4u*)(proj + (size_t)r2 * IN_COLS + sc_pc0 + 256);
#pragma unroll
      for (int j = 0; j < 4; ++j) { sp1[2 * j] = t_s >= 1 ? bflo(c1[j]) * bflo(x1v[j]) : 0.f; sp1[2 * j + 1] = t_s >= 1 ? bfhi(c1[j]) * bfhi(x1v[j]) : 0.f;
                                    sp2[2 * j] = t_s >= 2 ? bflo(c2[j]) * bflo(x2v[j]) : 0.f; sp2[2 * j + 1] = t_s >= 2 ? bfhi(c2[j]) * bfhi(x2v[j]) : 0.f; } }
    { const size_t ro = (size_t)sc_rs * IN_COLS + sc_pc0; sbb = *(const v4u*)(proj + ro); scc = *(const v4u*)(proj + ro + 128); sxx = *(const v4u*)(proj + ro + 256); snb = sbb; snc = scc; snx = sxx; }
    auto sc_prefetch = [&]() { if (sc_on && sc_i + 1 < 32) { const size_t ro = (size_t)(sc_rs + sc_i + 1) * IN_COLS + sc_pc0; snb = *(const v4u*)(proj + ro); snc = *(const v4u*)(proj + ro + 128); snx = *(const v4u*)(proj + ro + 256); } };
    auto sc_step = [&]() { if (sc_on && sc_i < 32) {
            float y[8]; float ss = 0.f;
#pragma unroll
            for (int j = 0; j < 4; ++j) {
                const float pa = bflo(scc[j]) * bflo(sxx[j]), pb = bfhi(scc[j]) * bfhi(sxx[j]);
                y[2 * j] = bflo(sbb[j]) * (sw0[2 * j] * sp2[2 * j] + sw1[2 * j] * sp1[2 * j] + sw2[2 * j] * pa);
                y[2 * j + 1] = bfhi(sbb[j]) * (sw0[2 * j + 1] * sp2[2 * j + 1] + sw1[2 * j + 1] * sp1[2 * j + 1] + sw2[2 * j + 1] * pb);
                sp2[2 * j] = sp1[2 * j]; sp2[2 * j + 1] = sp1[2 * j + 1]; sp1[2 * j] = pa; sp1[2 * j + 1] = pb;
                ss += y[2 * j] * y[2 * j] + y[2 * j + 1] * y[2 * j + 1]; }
            ss += __shfl_xor(ss, 1); ss += __shfl_xor(ss, 2); ss += __shfl_xor(ss, 4); ss += __shfl_xor(ss, 8);
            const float rstd = 1.0f / sqrtf(ss * (1.0f / 128.0f) + EPS);
            v4u o;
#pragma unroll
            for (int j = 0; j < 4; ++j) o[j] = pk2(y[2 * j] * rstd * sgn[2 * j], y[2 * j + 1] * rstd * sgn[2 * j + 1]);
            *(v4u*)(ycat + (size_t)(sc_rs + sc_i) * DM + 1024 + sc_c0) = o;
            sbb = snb; scc = snc; sxx = snx; ++sc_i; } };
#pragma unroll 1
    for (int u = F.vcu; u < 1024; u += F.G) {
        const int head = u & 3, bt = u >> 2, b = bt >> 6, tt = bt & 63;
        int tz = threadIdx.x; asm volatile("" : "+v"(tz));
        const int tid = tz, lane = tz & 63, fr = lane & 15, fq = lane >> 4;
        const int rowbase = b * SEQ + tt * LRU_T;
        v4u aub[8][2];
#pragma unroll
        for (int m = 0; m < 8; ++m)
#pragma unroll
            for (int n = 0; n < 2; ++n) aub[m][n] = au[((size_t)u * 16 + m * 2 + n) * 512 + F.wave * 64 + lane];
        { const int half = tid >> 8, ch = tid & 255; const int n0 = (tt + 1) >> 1; const int kbeg = half ? n0 : 0, cnt = half ? (tt - n0) : n0;
            const f32x2* cp = car + (size_t)(b * 64) * LRU_W + head * LRU_HD + ch; f32x2 v[32];
#pragma unroll
            for (int q = 0; q < 32; ++q) { int k = kbeg + q; k = k > 63 ? 63 : k; v[q] = cp[(size_t)k * LRU_W]; }
            float A = 1.f, H = 0.f;
#pragma unroll
            for (int q = 0; q < 32; ++q) { const float a = q < cnt ? v[q].x : 1.f, hh = q < cnt ? v[q].y : 0.f; H = a * H + hh; A = a * A; }
            if (half == 0) ((LAS float*)(lds + LRU_HIN))[ch] = H; else { ((LAS float*)(lds + LRU_HIN2))[ch] = A; ((LAS float*)(lds + LRU_HIN2))[256 + ch] = H; } }
#pragma unroll
        for (int i = 0; i < 8; ++i) { const int p = tid + 512 * i, t = p >> 5, cp = p & 31;
            const v4u v = *(const v4u*)(proj + (size_t)(rowbase + t) * IN_COLS + 1024 + head * LRU_HD + cp * 8);
            *(LAS v4u*)(lds + LRU_G + t * 528 + cp * 16) = v; }
        __syncthreads();
        float hc[2];
#pragma unroll
        for (int n = 0; n < 2; ++n) { const int jj = F.wave * 32 + n * 16 + fr; hc[n] = ((LAS float*)(lds + LRU_HIN2))[jj] * ((LAS float*)(lds + LRU_HIN))[jj] + ((LAS float*)(lds + LRU_HIN2))[256 + jj]; }
#pragma unroll
        for (int m = 0; m < 8; ++m) {
            sc_prefetch();
            float ssq[4] = {0.f, 0.f, 0.f, 0.f};
#pragma unroll
            for (int n = 0; n < 2; ++n) {
                const int j = F.wave * 32 + n * 16 + fr;
                float P[4], Q[4];
                { const float a0 = __builtin_amdgcn_exp2f(bflo(aub[m][n][0])); P[0] = a0; Q[0] = bfhi(aub[m][n][0]); }
#pragma unroll
                for (int r = 1; r < 4; ++r) { const float a = __builtin_amdgcn_exp2f(bflo(aub[m][n][r])); Q[r] = a * Q[r - 1] + bfhi(aub[m][n][r]); P[r] = a * P[r - 1]; }
                float TP = P[3], TQ = Q[3];
                { const float pp = __shfl_up(TP, 16), pq = __shfl_up(TQ, 16); if (fq >= 1) { TQ = TP * pq + TQ; TP = TP * pp; } }
                { const float pp = __shfl_up(TP, 32), pq = __shfl_up(TQ, 32); if (fq >= 2) { TQ = TP * pq + TQ; TP = TP * pp; } }
                float EP = __shfl_up(TP, 16), EQ = __shfl_up(TQ, 16); if (fq == 0) { EP = 1.f; EQ = 0.f; }
                const float hin = EP * hc[n] + EQ;
                const float hnew = TP * hc[n] + TQ;
                hc[n] = __shfl(hnew, fr + 48);
#pragma unroll
                for (int r = 0; r < 4; ++r) { const int t = m * 16 + 4 * fq + r; const float h = P[r] * hin + Q[r];
                    LAS unsigned short* gp = (LAS unsigned short*)(lds + LRU_G + t * 528 + j * 2);
                    const float gt = bf2f(*gp);
                    const float y = h * gt * fast_sigmoid(1.5957691216057308f * (gt + 0.044715f * gt * gt * gt));
                    ssq[r] += y * y; *gp = (unsigned short)f2bf(y); }
            }
#pragma unroll
            for (int r = 0; r < 4; ++r) { float sx = ssq[r]; sx += __shfl_xor(sx, 1); sx += __shfl_xor(sx, 2); sx += __shfl_xor(sx, 4); sx += __shfl_xor(sx, 8);
                if (fr == 0) ((LAS float*)(lds + LRU_PS))[(m * 16 + 4 * fq + r) * 8 + F.wave] = sx; }
            sc_step();
        }
        __syncthreads();
        if (tid < 128) { const LAS float* ps = (const LAS float*)(lds + LRU_PS) + tid * 8; float sx = 0.f;
#pragma unroll
            for (int w = 0; w < 8; ++w) sx += ps[w];
            ((LAS float*)(lds + LRU_RS))[tid] = 1.0f / sqrtf(sx * (1.0f / LRU_HD) + EPS); }
        __syncthreads();
#pragma unroll
        for (int i = 0; i < 8; ++i) { const int p = tid + 512 * i, t = p >> 5, cp = p & 31;
            const v4u v = *(const LAS v4u*)(lds + LRU_G + t * 528 + cp * 16); const float rs = ((const LAS float*)(lds + LRU_RS))[t];
            const float* gp = F.lru_out_g + head * LRU_HD + cp * 8; v4u o;
#pragma unroll
            for (int jx = 0; jx < 4; ++jx) o[jx] = pk2(bflo(v[jx]) * rs * gp[2 * jx], bfhi(v[jx]) * rs * gp[2 * jx + 1]);
            *(v4u*)(ycat + (size_t)(rowbase + t) * DM + head * LRU_HD + cp * 8) = o; }
        __syncthreads();
    }
    while (sc_on && sc_i < 32) { sc_prefetch(); sc_step(); }
}

constexpr int RT_TILE = 0;
constexpr int RT_TILE_W = 2 * 16 * 264 * 2;
constexpr int RT_LOG = 0;
constexpr int RT_ECNT = 8 * RT_TILE_W;
__device__ __forceinline__ void router_phase(const Frame& F) {
    LAS unsigned char* lds = F.lds;
    const float* mod = (const float*)(F.ws + WS_MOD);
    unsigned char* h2 = (unsigned char*)(F.ws + WS_H);
    const bf16* wf = (const bf16*)(F.ws + WS_WRT);
    int* ltok = (int*)(F.ws + WS_LTOK); float* lgate = (float*)(F.ws + WS_LGATE); int* tokslot = (int*)(F.ws + WS_TOKSLOT);
    unsigned* gcnt = (unsigned*)(F.ws + WS_CTL) + CW_GCNT;
    const bf16* x1 = (const bf16*)(F.ws + WS_X1B); const float* rowss = (const float*)(F.ws + WS_ROWSS);
    for (int tb = F.vcu; tb < NTOK / 128; tb += F.G) {
        int tz = threadIdx.x; asm volatile("" : "+v"(tz));
        const int tid = tz, lane = tz & 63, fr = lane & 15, fq = lane >> 4;
        const int tok0 = tb * 128, b = tok0 / SEQ, wtok0 = tok0 + F.wave * 16;
        if (tid < 64) ((LAS int*)(lds + RT_ECNT))[tid] = 0;
        float rstd;
        { const f32x4 p0 = *(const f32x4*)(rowss + (size_t)(wtok0 + fr) * 32 + 8 * fq), p1 = *(const f32x4*)(rowss + (size_t)(wtok0 + fr) * 32 + 8 * fq + 4);
          float ssum = ((p0.x + p0.y) + (p0.z + p0.w)) + ((p1.x + p1.y) + (p1.z + p1.w)); ssum += __shfl_xor(ssum, 16); ssum += __shfl_xor(ssum, 32);
          rstd = 1.0f / sqrtf(ssum * (1.0f / DM) + EPS); }
        LAS unsigned char* tile = lds + RT_TILE + F.wave * RT_TILE_W;
        f32x4 acc[3];
#pragma unroll
        for (int n = 0; n < 3; ++n) acc[n] = (f32x4){0.f, 0.f, 0.f, 0.f};
        struct WSet { bf16x8 w[3][2]; };
        auto wload = [&](WSet& W, int cc, int t) { const bf16* wp = wf + ((size_t)((8 * cc + t) * 3) * 2 * 64 + lane) * 8;
#pragma unroll
            for (int n = 0; n < 3; ++n) { W.w[n][0] = *(const bf16x8*)(wp + (size_t)n * 1024); W.w[n][1] = *(const bf16x8*)(wp + (size_t)n * 1024 + 512); } };
        auto kstep = [&](const WSet& W, int t) { const bf16x8 th = *(const LAS bf16x8*)(tile + fr * 528 + (32 * t + 8 * fq) * 2), tl8 = *(const LAS bf16x8*)(tile + 16 * 528 + fr * 528 + (32 * t + 8 * fq) * 2);
#pragma unroll
            for (int n = 0; n < 3; ++n) { acc[n] = __builtin_amdgcn_mfma_f32_16x16x32_bf16(W.w[n][0], th, acc[n], 0, 0, 0);
                acc[n] = __builtin_amdgcn_mfma_f32_16x16x32_bf16(W.w[n][1], th, acc[n], 0, 0, 0);
                acc[n] = __builtin_amdgcn_mfma_f32_16x16x32_bf16(W.w[n][0], tl8, acc[n], 0, 0, 0); } };
        WSet W0, W1, W2, W3; v2u xb[16], xn[16];
        { const int c0 = (F.wave + F.vcu) & 7; const int kc0 = 256 * c0 + 4 * lane;
#pragma unroll
            for (int r = 0; r < 16; ++r) xb[r] = *(const v2u*)(x1 + (size_t)(wtok0 + r) * DM + kc0);
            wload(W0, c0, 0); wload(W1, c0, 1); wload(W2, c0, 2); }
#pragma unroll 1
        for (int ci = 0; ci < 8; ++ci) {
            const int c = (ci + F.wave + F.vcu) & 7, cn = (ci + 1 + F.wave + F.vcu) & 7;
            const int kc = 256 * c + 4 * lane, kcn = 256 * cn + 4 * lane;
            const f32x4 gsv = *(const f32x4*)(F.g_ffn + kc) * (*(const f32x4*)(mod + (size_t)b * 6 * DM + 4 * DM + kc) + 1.0f), shv = *(const f32x4*)(mod + (size_t)b * 6 * DM + 3 * DM + kc);
#pragma unroll
            for (int r = 0; r < 16; ++r) xn[r] = *(const v2u*)(x1 + (size_t)(wtok0 + r) * DM + kcn);
            __builtin_amdgcn_sched_barrier(0);
#pragma unroll
            for (int r = 0; r < 16; ++r) { const float rs = __builtin_bit_cast(float, __builtin_amdgcn_readlane(__builtin_bit_cast(int, rstd), r));
                const f32x4 v = (f32x4){bflo(xb[r].x), bfhi(xb[r].x), bflo(xb[r].y), bfhi(xb[r].y)} * rs * gsv + shv;
                *(unsigned*)(h2 + (size_t)(wtok0 + r) * DM + kc) = pack4_fp8(v.x * F8S_H2, v.y * F8S_H2, v.z * F8S_H2, v.w * F8S_H2);
                const unsigned a = f2bf(v.x), bq = f2bf(v.y), cq = f2bf(v.z), d = f2bf(v.w);
                v2u hw, lw; hw.x = a | (bq << 16); hw.y = cq | (d << 16); lw.x = pk2(v.x - bf2f(a), v.y - bf2f(bq)); lw.y = pk2(v.z - bf2f(cq), v.w - bf2f(d));
                *(LAS v2u*)(tile + r * 528 + lane * 8) = hw; *(LAS v2u*)(tile + 16 * 528 + r * 528 + lane * 8) = lw; }
#define RT_SB __builtin_amdgcn_sched_barrier(0)
            wload(W3, c, 3); RT_SB; kstep(W0, 0); RT_SB;
            wload(W0, c, 4); RT_SB; kstep(W1, 1); RT_SB;
            wload(W1, c, 5); RT_SB; kstep(W2, 2); RT_SB;
            wload(W2, c, 6); RT_SB; kstep(W3, 3); RT_SB;
            wload(W3, c, 7); RT_SB; kstep(W0, 4); RT_SB;
            wload(W0, cn, 0); RT_SB; kstep(W1, 5); RT_SB;
            wload(W1, cn, 1); RT_SB; kstep(W2, 6); RT_SB;
            wload(W2, cn, 2); RT_SB; kstep(W3, 7); RT_SB;
#undef RT_SB
#pragma unroll
            for (int r = 0; r < 16; ++r) xb[r] = xn[r];
        }
        __syncthreads();
        { const int tl = F.wave * 16 + fr;
#pragma unroll
            for (int n = 0; n < 3; ++n)
#pragma unroll
                for (int r = 0; r < 4; ++r) ((LAS float*)(lds + RT_LOG))[tl * 49 + n * 16 + 4 * fq + r] = acc[n][r]; }
        __syncthreads();
        int e0 = 0, e1 = 0, lp0 = 0, lp1 = 0; float gt0 = 0.f, gt1 = 0.f;
        if (tid < 128) {
            const LAS float* lg = (const LAS float*)(lds + RT_LOG) + tid * 49;
            float gl[4]; int gi = 0; float gm;
#pragma unroll
            for (int g = 0; g < 4; ++g) gl[g] = lg[32 + g] + F.b_rg[g];
            gm = gl[0];
#pragma unroll
            for (int g = 1; g < 4; ++g) if (gl[g] > gm) { gm = gl[g]; gi = g; }
            float gsum = 0.f;
#pragma unroll
            for (int g = 0; g < 4; ++g) gsum += __expf(gl[g] - gm);
            const float gp = 1.0f / gsum;
            float el[8];
#pragma unroll
            for (int j = 0; j < 8; ++j) el[j] = lg[gi * 8 + j] + F.b_re[gi * 8 + j];
            int i0 = 0; float m0 = el[0];
#pragma unroll
            for (int j = 1; j < 8; ++j) if (el[j] > m0) { m0 = el[j]; i0 = j; }
            int i1 = -1; float m1 = -3.0e38f;
#pragma unroll
            for (int j = 0; j < 8; ++j) if (j != i0 && el[j] > m1) { m1 = el[j]; i1 = j; }
            const float ex = __expf(m1 - m0); const float p0 = 1.0f / (1.0f + ex), p1 = ex / (1.0f + ex);
            e0 = gi * 8 + i0; e1 = gi * 8 + i1; gt0 = gp * p0; gt1 = gp * p1;
            lp0 = __hip_atomic_fetch_add((LAS int*)(lds + RT_ECNT) + e0, 1, __ATOMIC_RELAXED, __HIP_MEMORY_SCOPE_WORKGROUP); lp1 = __hip_atomic_fetch_add((LAS int*)(lds + RT_ECNT) + e1, 1, __ATOMIC_RELAXED, __HIP_MEMORY_SCOPE_WORKGROUP);
        }
        __syncthreads();
        if (tid < 32) { const int n = ((LAS int*)(lds + RT_ECNT))[tid]; int base = 0; if (n > 0) base = (int)__hip_atomic_fetch_add(gcnt + tid, (unsigned)n, __ATOMIC_RELAXED, __HIP_MEMORY_SCOPE_AGENT);
            ((LAS int*)(lds + RT_ECNT))[32 + tid] = base; }
        __syncthreads();
        if (tid < 128) { const int tk = tok0 + tid;
            const int q0 = ((LAS int*)(lds + RT_ECNT))[32 + e0] + lp0, q1 = ((LAS int*)(lds + RT_ECNT))[32 + e1] + lp1;
            ltok[e0 * LIST_CAP + q0] = tk; ltok[e1 * LIST_CAP + q1] = tk; *(f32x2*)(lgate + (size_t)tk * 2) = (f32x2){gt0, gt1};
            tokslot[tk * 2] = (e0 << 16) | q0; tokslot[tk * 2 + 1] = (e1 << 16) | q1; }
        __syncthreads();
    }
}

__device__ __forceinline__ void moe_table(const Frame& F) {
    LAS int* tab = (LAS int*)(F.lds + LDS_TAB);
    const unsigned* gcnt = (const unsigned*)(F.ws + WS_CTL) + CW_GCNT;
    if (F.tid < 32) tab[64 + F.tid] = (int)__hip_atomic_load(gcnt + F.tid, __ATOMIC_RELAXED, __HIP_MEMORY_SCOPE_AGENT);
    __syncthreads();
    if (F.tid == 0) { int acc = 0; for (int e = 0; e < 32; ++e) { tab[e] = acc; acc += (tab[64 + e] + 255) >> 8; } tab[32] = acc; }
    __syncthreads();
    if (F.tid < MAX_TILES) { int e = 0; for (int j = 1; j < 32; ++j) e = (tab[j] <= F.tid) ? j : e; tab[128 + F.tid] = e; }
    __syncthreads();
}

__device__ __forceinline__ void final_phase(const Frame& F) {
    const LAS int* tab = (const LAS int*)(F.lds + LDS_TAB);
    const float* mod = (const float*)(F.ws + WS_MOD); const int* tokslot = (const int*)(F.ws + WS_TOKSLOT); const float* tokgate = (const float*)(F.ws + WS_LGATE); const unsigned char* yexp = (const unsigned char*)(F.ws + WS_YEXP);
    const int gw = F.vcu * 8 + F.wave, NGW = F.G * 8; constexpr int RPW = NTOK / 2048;
    for (int chunk = gw; chunk < 2048; chunk += NGW) {
        const int row_begin = chunk * RPW, b = row_begin / SEQ;
        f32x4 g2[8], gf[8];
#pragma unroll
        for (int j = 0; j < 8; ++j) { const int c = 4 * F.lane + 256 * j; g2[j] = *(const f32x4*)(mod + (size_t)b * 6 * DM + 5 * DM + c); gf[j] = *(const f32x4*)(F.g_final + c); }
        int sra, srb; float gta, gtb;
        { const int rr = F.lane & 15; const v2u ts = *(const v2u*)(tokslot + (size_t)(row_begin + rr) * 2); const f32x2 gg = *(const f32x2*)(tokgate + (size_t)(row_begin + rr) * 2);
          sra = tab[ts.x >> 16] * 256 + (int)(ts.x & 0xffffu); srb = tab[ts.y >> 16] * 256 + (int)(ts.y & 0xffffu); gta = gg.x; gtb = gg.y; }
#pragma unroll 2
        for (int r = 0; r < RPW; ++r) {
            const int row = row_begin + r;
            const size_t ra = (size_t)__builtin_amdgcn_readlane(sra, r), rb = (size_t)__builtin_amdgcn_readlane(srb, r);
            const float ga = __builtin_bit_cast(float, __builtin_amdgcn_readlane(__builtin_bit_cast(int, gta), r)) * (1.0f / F8S_Y), gb = __builtin_bit_cast(float, __builtin_amdgcn_readlane(__builtin_bit_cast(int, gtb), r)) * (1.0f / F8S_Y);
            const v2u* xr = (const v2u*)((const bf16*)(F.ws + WS_X1B) + (size_t)row * DM) + F.lane;
            const unsigned* ya = (const unsigned*)(yexp + ra * DM) + F.lane; const unsigned* yb = (const unsigned*)(yexp + rb * DM) + F.lane;
            f32x4 v[8]; float s = 0.f;
#pragma unroll
            for (int j = 0; j < 8; ++j) { const v2u xw = xr[64 * j]; const f32x4 xv = {bflo(xw.x), bfhi(xw.x), bflo(xw.y), bfhi(xw.y)}; const int a = (int)ya[64 * j], bq = (int)yb[64 * j];
                f32x4 f; f.x = ga * __builtin_amdgcn_cvt_f32_fp8(a, 0) + gb * __builtin_amdgcn_cvt_f32_fp8(bq, 0); f.y = ga * __builtin_amdgcn_cvt_f32_fp8(a, 1) + gb * __builtin_amdgcn_cvt_f32_fp8(bq, 1);
                f.z = ga * __builtin_amdgcn_cvt_f32_fp8(a, 2) + gb * __builtin_amdgcn_cvt_f32_fp8(bq, 2); f.w = ga * __builtin_amdgcn_cvt_f32_fp8(a, 3) + gb * __builtin_amdgcn_cvt_f32_fp8(bq, 3);
                v[j] = xv + g2[j] * f; s += (v[j].x * v[j].x + v[j].y * v[j].y) + (v[j].z * v[j].z + v[j].w * v[j].w); }
            const float rstd = 1.0f / sqrtf(wave_sum(s) * (1.0f / DM) + EPS);
            f32x4* o = (f32x4*)(F.out + (size_t)row * DM) + F.lane;
#pragma unroll
            for (int j = 0; j < 8; ++j) o[64 * j] = v[j] * rstd * gf[j];
        }
    }
}

struct Args { const float* in[26]; float* out; unsigned char* ws; int ph_lo, ph_hi; };
__global__ void __launch_bounds__(512, 2) hymba_fwd(Args args) {
    extern __shared__ __attribute__((aligned(16))) unsigned char lds_raw[];
    Frame F;
    F.lds = (LAS unsigned char*)lds_raw;
    F.tid = threadIdx.x; F.lane = F.tid & 63; F.wave = __builtin_amdgcn_readfirstlane(F.tid >> 6);
    F.G = gridDim.x; { const int bx = blockIdx.x; F.vcu = (F.G % 8 == 0) ? (bx % 8) * (F.G / 8) + bx / 8 : bx; }
    F.ws = args.ws; F.out = args.out;
    F.x = args.in[0]; F.c = args.in[1]; F.w_ada = args.in[2]; F.b_ada = args.in[3]; F.g_mix = args.in[4]; F.w_in = args.in[5]; F.lru_conv_w = args.in[6]; F.lru_conv_b = args.in[7];
    F.lru_w_a = args.in[8]; F.lru_b_a = args.in[9]; F.lru_w_x = args.in[10]; F.lru_b_x = args.in[11]; F.lru_lambda = args.in[12]; F.lru_out_g = args.in[13]; F.sc_conv_w = args.in[14];
    F.sc_out_g = args.in[15]; F.w_out = args.in[16]; F.g_ffn = args.in[17]; F.w_rg = args.in[18]; F.b_rg = args.in[19]; F.w_re = args.in[20]; F.b_re = args.in[21];
    F.w1 = args.in[22]; F.w3 = args.in[23]; F.w2 = args.in[24]; F.g_final = args.in[25];
    volatile LAS unsigned* MISC = (volatile LAS unsigned*)(F.lds + LDS_MISC);
    if (F.tid < 64) MISC[F.tid] = 0u;
    __syncthreads();
    unsigned* ctl = (unsigned*)(F.ws + WS_CTL);
    XcdBarrier bar; bar.bar = ctl + CW_BAR; bar.x = 0; bar.st = nullptr;
    if (MK_N_LAUNCHES == 1) bar = xcd_barrier_post(ctl + CW_BAR, MISC + 8);
#define GRID_BAR() do { if (MK_N_LAUNCHES == 1) xcd_barrier(bar); } while (0)
    const int lo = args.ph_lo, hi = args.ph_hi;
#ifndef PH_MASK
#define PH_MASK 0x3ff
#endif
#define IN(k) (((PH_MASK >> (k)) & 1) && lo <= (k) && (k) < hi)
#define BOTH(k) (IN(k) && IN((k) + 1))
    const float* mod = (const float*)(F.ws + WS_MOD);

    if (IN(0)) { { phase0(F); } if (BOTH(0)) GRID_BAR(); }
    if (IN(1)) { { const int gw = F.vcu * 8 + F.wave, NGW = F.G * 8;
        for (int chunk = gw; chunk < 2048; chunk += NGW) norm_rows(F, F.x, F.g_mix, mod, mod + DM, (bf16*)(F.ws + WS_H), chunk * 16, 16, (LAS float*)F.lds, false); }
        if (BOTH(1)) GRID_BAR();
    }
    if (IN(2)) { { pg8::DenseOrder<DM * 2> S; S.init(F.ws + WS_H, F.ws + WS_WIN, NTOK, IN_COLS, F.G, (int)blockIdx.x);
        pg8::EpiBf16 E{(bf16*)(F.ws + WS_PROJ), IN_COLS};
        pg8::gemm_phase<DM * 2, false, false>(F.lds, S, E, nullptr); }
        if (BOTH(2)) GRID_BAR();
    }
    if (IN(3)) { { lru_phase<false>(F); } if (BOTH(3)) GRID_BAR(); }
    if (IN(4)) { { lru_final_phase(F); sconv_phase(F, 1); } if (BOTH(4)) GRID_BAR(); }
    if (IN(5)) { {
        pg8::DenseOrder<DM * 2> S; S.init(F.ws + WS_YCAT, F.ws + WS_WOUT, NTOK, DM, F.G, (int)blockIdx.x);
        pg8::EpiResid E{F.x, (bf16*)(F.ws + WS_X1B), mod + 2 * DM, (float*)(F.ws + WS_ROWSS)};
        pg8::gemm_phase<DM * 2, false, false>(F.lds, S, E, nullptr); }
        if (BOTH(5)) GRID_BAR();
    }
    if (IN(6)) { { router_phase(F); } if (BOTH(6)) GRID_BAR(); }
    if (IN(7)) { { moe_table(F);
        pg8::MoeOrder<DM, 8, 128, true> S{(const char*)(F.ws + WS_H), (const char*)(F.ws + WS_W13), (const LAS int*)(F.lds + LDS_TAB), F.G, (int)blockIdx.x, (size_t)DM * DM};
        pg8::EpiSwiglu E{(unsigned char*)(F.ws + WS_HID)};
        pg8::gemm_phase<DM, true, true>(F.lds, S, E, (const int*)(F.ws + WS_LTOK)); }
        if (BOTH(7)) GRID_BAR();
    }
    if (IN(8)) { { moe_table(F);
        pg8::MoeOrder<FF, 8, 256, false> S{(const char*)(F.ws + WS_HID), (const char*)(F.ws + WS_W2), (const LAS int*)(F.lds + LDS_TAB), F.G, (int)blockIdx.x, (size_t)DM * FF};
        pg8::EpiDown E{(unsigned char*)(F.ws + WS_YEXP)};
        pg8::gemm_phase<FF, true, false>(F.lds, S, E, nullptr); }
        if (BOTH(8)) GRID_BAR();
    }
    if (IN(9)) { moe_table(F); final_phase(F); }
#undef IN
#undef BOTH
}

extern "C" void kernel_launch(void* const* d_in, const int* in_sizes, int n_in, void* d_out, int out_size, void* d_ws, size_t ws_size, hipStream_t stream) {
    static int grid = 0;
    if (grid == 0) {
        if (n_in != 26 || in_sizes[0] != NTOK * DM || out_size != NTOK * DM || ws_size < WS_END) {
            fprintf(stderr, "kernel_launch: unexpected problem (n_in %d, in0 %d, out %d, ws %zu; need ws >= %zu)\n", n_in, n_in > 0 ? in_sizes[0] : -1, out_size, ws_size, (size_t)WS_END); grid = -1; return; }
        int dev = 0, cus = 0, per_cu = 0;
        if (hipGetDevice(&dev) != hipSuccess || hipDeviceGetAttribute(&cus, hipDeviceAttributeMultiprocessorCount, dev) != hipSuccess) { grid = -1; return; }
        if (hipFuncSetAttribute((const void*)hymba_fwd, hipFuncAttributeMaxDynamicSharedMemorySize, LDS_BYTES) != hipSuccess) { fprintf(stderr, "kernel_launch: hipFuncSetAttribute failed\n"); grid = -1; return; }
        if (hipOccupancyMaxActiveBlocksPerMultiprocessor(&per_cu, (const void*)hymba_fwd, 512, LDS_BYTES) != hipSuccess || per_cu < 1)
            fprintf(stderr, "kernel_launch: occupancy query reports %d workgroups per CU\n", per_cu);
        (void)hipGetLastError();
        grid = cus;
    }
    if (grid < 0) return;
    if (hipMemsetAsync((char*)d_ws + WS_CTL, 0, CTL_ZERO_BYTES, stream) != hipSuccess) { fprintf(stderr, "kernel_launch: memset failed\n"); return; }
    Args a{};
    for (int i = 0; i < 26; ++i) a.in[i] = (const float*)d_in[i];
    a.out = (float*)d_out; a.ws = (unsigned char*)d_ws;
    if (MK_N_LAUNCHES == 1) {
        a.ph_lo = 0; a.ph_hi = N_PHASES;
        hipLaunchKernelGGL(hymba_fwd, dim3(grid), dim3(512), LDS_BYTES, stream, a);
    } else {
        for (int p = 0; p < N_PHASES; ++p) { a.ph_lo = p; a.ph_hi = p + 1; hipLaunchKernelGGL(hymba_fwd, dim3(grid), dim3(512), LDS_BYTES, stream, a); }
    }
    const hipError_t le = hipPeekAtLastError();
    if (le != hipSuccess) fprintf(stderr, "kernel_launch: launch failed: %s\n", hipGetErrorName(le));
}
```

```cpp
#include <hip/hip_runtime.h>
#include <cstdio>
#include <cstdint>

#ifndef MK_N_LAUNCHES
#define MK_N_LAUNCHES 1
#endif
constexpr int N_PHASES = 10;

constexpr int DM = 2048, NB = 4, SEQ = 8192, NTOK = NB * SEQ;
constexpr int LRU_W = 1024, LRU_HD = 256, SC_W = 1024, IN_COLS = 5120;
constexpr int NEXP = 32, FF = 1024;
constexpr int LIST_CAP = NTOK;
constexpr float EPS = 1e-6f;
constexpr int MAX_TILES = 288;

constexpr size_t MiB = 1u << 20;
constexpr size_t WS_CTL = 0, CTL_ZERO_BYTES = 65536;
constexpr size_t WS_MOD = 1 * MiB;
constexpr size_t WS_CAR = 2 * MiB;
constexpr size_t WS_WRT = 4 * MiB;
constexpr size_t WS_LTOK = 5 * MiB;
constexpr size_t WS_LGATE = 9 * MiB;
constexpr size_t WS_TOKSLOT = 13 * MiB;
constexpr size_t WS_WLRU = 14 * MiB;
constexpr size_t WS_WIN = 16 * MiB;
constexpr size_t WS_WOUT = 36 * MiB;
constexpr size_t WS_W13 = 44 * MiB;
constexpr size_t WS_X1B = 172 * MiB;
constexpr size_t WS_W2 = 300 * MiB;
constexpr size_t WS_H = 428 * MiB;
constexpr size_t WS_PROJ = 556 * MiB;
constexpr size_t WS_YCAT = 876 * MiB;
constexpr size_t WS_ROWSS = 556 * MiB;
constexpr size_t WS_HID = 556 * MiB;
constexpr size_t WS_YEXP = 700 * MiB;
constexpr size_t WS_END = 1004 * MiB;
constexpr int CW_GCNT = 64;
constexpr int CW_BAR = 4096;

constexpr int LDS_BYTES = 160 * 1024;
constexpr int LDS_MISC = 156 * 1024;
constexpr int LDS_TAB = 152 * 1024;

#define GAS __attribute__((address_space(1)))
#define LAS __attribute__((address_space(3)))
typedef unsigned short bf16;
typedef unsigned v4u __attribute__((ext_vector_type(4)));
typedef unsigned v2u __attribute__((ext_vector_type(2)));
typedef float f32x4 __attribute__((ext_vector_type(4)));
typedef float f32x2 __attribute__((ext_vector_type(2)));
typedef short bf16x8 __attribute__((ext_vector_type(8)));
#define LDS_WAIT() asm volatile("s_waitcnt lgkmcnt(0)" ::: "memory")
#define VM_WAIT() asm volatile("s_waitcnt vmcnt(0)" ::: "memory")

__device__ __forceinline__ unsigned f2bf(float f) { unsigned u = __builtin_bit_cast(unsigned, f); return (u + 0x7fffu + ((u >> 16) & 1u)) >> 16; }
__device__ __forceinline__ unsigned pk2(float lo, float hi) { return f2bf(lo) | (f2bf(hi) << 16); }
__device__ __forceinline__ float bf2f(unsigned b) { return __builtin_bit_cast(float, b << 16); }
__device__ __forceinline__ float bflo(unsigned w) { return __builtin_bit_cast(float, w << 16); }
__device__ __forceinline__ float bfhi(unsigned w) { return __builtin_bit_cast(float, w & 0xffff0000u); }
__device__ __forceinline__ unsigned cvt_pk_bf16(float lo, float hi) { unsigned r; asm volatile("v_cvt_pk_bf16_f32 %0, %1, %2" : "=v"(r) : "v"(lo), "v"(hi)); return r; }
typedef int v4i __attribute__((ext_vector_type(4)));
typedef int v8i __attribute__((ext_vector_type(8)));
constexpr float FP8_MAX = 448.0f;
constexpr float F8S_W = 256.0f, F8S_H2 = 16.0f, F8S_HID = 8.0f, F8S_Y = 32.0f;
__device__ __forceinline__ float clamp8(float x) { return fminf(fmaxf(x, -FP8_MAX), FP8_MAX); }
__device__ __forceinline__ unsigned pack4_fp8(float a, float b, float c, float d) { int p = __builtin_amdgcn_cvt_pk_fp8_f32(clamp8(a), clamp8(b), 0, false); p = __builtin_amdgcn_cvt_pk_fp8_f32(clamp8(c), clamp8(d), p, true); return (unsigned)p; }
__device__ __forceinline__ float fast_sigmoid(float x) { return __builtin_amdgcn_rcpf(1.0f + __builtin_amdgcn_exp2f(-1.4426950408889634f * x)); }
__device__ __forceinline__ float wave_sum(float v) {
#pragma unroll
    for (int o = 1; o < 64; o <<= 1) v += __shfl_xor(v, o);
    return v;
}

#define XB_TMO      128
#define XB_XCNT(j)  (256  + 64 * (j))
#define XB_XSUB(j)  (1280 + 64 * (j))
#define XB_XGEN(j)  (2304 + 64 * (j))
#define XB_TOP      3328
#define XB_TOPGEN   3392
#define XCD_BAR_WORDS 3456
#define XB_SPIN_CAP (1u << 18)
__device__ __forceinline__ unsigned xb_ld(unsigned* p)              { return __hip_atomic_load(p, __ATOMIC_RELAXED, __HIP_MEMORY_SCOPE_AGENT); }
__device__ __forceinline__ unsigned xb_add(unsigned* p, unsigned v) { return __hip_atomic_fetch_add(p, v, __ATOMIC_RELAXED, __HIP_MEMORY_SCOPE_AGENT); }
__device__ __forceinline__ unsigned xb_xcc_id() { return (unsigned)__builtin_amdgcn_s_getreg((3 << 11) | 20) & 0xFu; }
#define XB_SPIN(cond, bar) do { unsigned _sp = 0; while (cond) { __builtin_amdgcn_s_sleep(1); \
    if ((++_sp & 255u) == 0u) { if (xb_ld(&(bar)[XB_TMO])) break; if (_sp > XB_SPIN_CAP) { atomicAdd(&(bar)[XB_TMO], 1u); break; } } } } while (0)
struct XcdBarrier { unsigned* bar; unsigned x; volatile LAS unsigned* st; };
__device__ __forceinline__ XcdBarrier xcd_barrier_post(unsigned* bar, volatile LAS unsigned* st) {
    XcdBarrier b; b.bar = bar; b.x = xb_xcc_id(); b.st = st;
    if (threadIdx.x == 0) (void)xb_add(&bar[XB_XCNT(b.x)], 1u);
    return b;
}
__device__ __forceinline__ void xcd_barrier_complete(unsigned* bar, unsigned x, unsigned& nloc, unsigned& nx) {
    const unsigned G = gridDim.x * gridDim.y * gridDim.z;
    unsigned sum, cnt, mine, sp = 0u;
    for (;;) {
        sum = 0u; cnt = 0u; mine = 0u;
#pragma unroll
        for (unsigned j = 0; j < 16; ++j) { const unsigned c = xb_ld(&bar[XB_XCNT(j)]); sum += c; cnt += (c > 0u) ? 1u : 0u; mine = (j == x) ? c : mine; }
        if (sum == G) break;
        __builtin_amdgcn_s_sleep(1);
        if ((++sp & 255u) == 0u) { if (xb_ld(&bar[XB_TMO])) break; if (sp > XB_SPIN_CAP) { atomicAdd(&bar[XB_TMO], 1u); break; } }
    }
    nloc = mine > 0u ? mine : 1u; nx = cnt > 0u ? cnt : 1u;
}
__device__ __forceinline__ void xcd_barrier(const XcdBarrier& b) {
    asm volatile("s_waitcnt vmcnt(0)" ::: "memory");
    __syncthreads();
    if (threadIdx.x == 0) {
        unsigned* bar = b.bar;
        __builtin_amdgcn_s_waitcnt(0);
        unsigned nloc = b.st[0], nx = b.st[1];
        if (nloc == 0u) { xcd_barrier_complete(bar, b.x, nloc, nx); b.st[0] = nloc; b.st[1] = nx; }
        const unsigned old = xb_add(&bar[XB_XSUB(b.x)], 1u);
        const unsigned gen = old / nloc;
        if (old + 1u == (gen + 1u) * nloc) {
            __builtin_amdgcn_fence(__ATOMIC_RELEASE, "agent");
            asm volatile("s_waitcnt vmcnt(0)" ::: "memory");
            const unsigned og = xb_add(&bar[XB_TOP], 1u);
            const unsigned tg = og / nx;
            if (og + 1u == (tg + 1u) * nx) xb_add(&bar[XB_TOPGEN], 1u);
            else XB_SPIN(xb_ld(&bar[XB_TOPGEN]) == tg, bar);
            __builtin_amdgcn_fence(__ATOMIC_ACQUIRE, "agent");
            xb_add(&bar[XB_XGEN(b.x)], 1u);
            asm volatile("s_waitcnt vmcnt(0)" ::: "memory");
        } else {
            XB_SPIN(xb_ld(&bar[XB_XGEN(b.x)]) == gen, bar);
            __builtin_amdgcn_fence(__ATOMIC_ACQUIRE, "agent");
            asm volatile("s_waitcnt vmcnt(0)" ::: "memory");
        }
    }
    __syncthreads();
}

namespace pg8 {
#ifndef PG8_ROLL_ALL
#define PG8_ROLL_ALL false
#endif
constexpr bool ROLL_ALL = PG8_ROLL_ALL;
constexpr int BM = 256, BK = 64, HALF = 128, HTB = HALF * BK * 2, STAGE_BYTES = 8 * HTB, NXCD = 8, WGM = 8;
__host__ __device__ __forceinline__ int lds_byte(int r, int c) { const int st = (r >> 4) * 2 + (c >> 5), rr = r & 15, cc = c & 31, ob = rr * 64 + cc * 2; return st * 1024 + (ob ^ (((ob >> 9) & 1) << 5)); }
__host__ __device__ __forceinline__ void stage_rc(int b, int& R, int& C) { const int st = b / 1024, sb = b % 1024, swz = sb ^ (((sb >> 9) & 1) << 5); R = (st >> 1) * 16 + swz / 64; C = (st & 1) * 32 + (swz % 64) / 2; }
__host__ __device__ __forceinline__ int perm32(int rho) { const int n = rho >> 4, i = rho & 15; return 8 * (i >> 2) + 4 * n + (i & 3); }

struct Unit {
    const char* aBase;
    const char* bBase;
    int row0, col0;
    int gbase, nvalid;
};

template <int KB>
struct DenseOrder {
    const char* A; const char* Bt; int nM, nN, nwg, G, c;
    __device__ __forceinline__ void init(const void* A_, const void* Bt_, int M, int N, int G_, int c_) { A = (const char*)A_; Bt = (const char*)Bt_; nM = M / BM; nN = N / BM; nwg = nM * nN; G = G_; c = c_; }
    __device__ __forceinline__ bool next(int i, Unit& u) const {
        const long L = (long)i * G + c; if (L >= nwg) return false;
        int wgid = (int)L; { const int q = nwg / NXCD, r = nwg % NXCD, xcd = wgid % NXCD, off = wgid / NXCD; wgid = (xcd < r ? xcd * (q + 1) : r * (q + 1) + (xcd - r) * q) + off; }
        const int nig = WGM * nN, gid = wgid / nig, fm = gid * WGM, gsz = (nM - fm) < WGM ? (nM - fm) : WGM;
        const int pm = fm + ((wgid % nig) % gsz), pn = (wgid % nig) / gsz;
        u.row0 = pm * BM; u.col0 = pn * BM; u.aBase = A + (size_t)pm * BM * KB; u.bBase = Bt + (size_t)pn * BM * KB; u.gbase = 0; u.nvalid = BM; return true;
    }
};
template <int KB, int NPN, int COLSTEP, bool GATHER_A>
struct MoeOrder {
    const char* A; const char* Bt; const LAS int* tab; int G, c; size_t bExpStride;
    __device__ __forceinline__ bool next(int i, Unit& u) const {
        const int ntile = __builtin_amdgcn_readfirstlane(tab[32]); const int nwg = ntile * NPN;
        const long L = (long)i * G + c; if (L >= nwg) return false;
        int wgid = (int)L; { const int q = nwg / NXCD, r = nwg % NXCD, xcd = wgid % NXCD, off = wgid / NXCD; wgid = (xcd < r ? xcd * (q + 1) : r * (q + 1) + (xcd - r) * q) + off; }
        const int mt = wgid / NPN, pn = wgid % NPN;
        const int e = __builtin_amdgcn_readfirstlane(tab[128 + mt]);
        const int ml = mt - __builtin_amdgcn_readfirstlane(tab[e]); const int cnt = __builtin_amdgcn_readfirstlane(tab[64 + e]);
        u.row0 = mt * BM; u.col0 = pn * COLSTEP; u.gbase = e * LIST_CAP + ml * BM; u.nvalid = (cnt - ml * BM) < BM ? (cnt - ml * BM) : BM;
        u.aBase = GATHER_A ? A : A + (size_t)mt * BM * KB;
        u.bBase = Bt + (size_t)e * bExpStride + (size_t)pn * BM * KB;
        return true;
    }
};

template <int KB  , bool FP8  , bool GATHER, class Epi, class Sched>
__device__ __forceinline__ void gemm_phase(LAS unsigned char* lds, const Sched& S, const Epi& E, const int* glist) {
    const int tid = threadIdx.x, wid = __builtin_amdgcn_readfirstlane(tid >> 6), lane = tid & 63, wr = wid >> 2, wc = wid & 3, fr = lane & 15, fq = lane >> 4;
    constexpr int nt = KB / 128; static_assert(!GATHER || FP8, "the gathered-A form exists for the rolled (fp8) K-loop only");
    unsigned voffA[2][2], nvoffA[2][2], voffB[2]; int RA[2], CA[2];
#pragma unroll
    for (int i = 0; i < 2; ++i) { int R, C; stage_rc(tid * 16 + i * 8192, R, C); const int Rb = Epi::PERM ? ((R & ~31) + perm32(R & 31)) : R; RA[i] = R; CA[i] = C;
        voffB[i] = (unsigned)(Rb * KB + C * 2);
#pragma unroll
        for (int h = 0; h < 2; ++h) { voffA[h][i] = (unsigned)((h * HALF + R) * KB + C * 2); nvoffA[h][i] = voffA[h][i]; } }
    constexpr size_t kstep = (size_t)(BK * 2);
    constexpr size_t hstep = (size_t)HALF * KB;
    const unsigned ldsw = (unsigned)wid * 1024u;
    const int aoff = lds_byte(wr * 64 + fr, fq * 8), boff = lds_byte(wc * 32 + fr, fq * 8);
#define PG8_SA(b, h) (((b) * 2 + (h)) * HTB)
#define PG8_SB(b, h) ((4 + (b) * 2 + (h)) * HTB)
#define PG8_STAGE_B(bufoff, gbase) do { _Pragma("unroll") for (int _i = 0; _i < 2; ++_i) \
        __builtin_amdgcn_global_load_lds((const unsigned*)((const char*)(gbase) + voffB[_i]), (LAS unsigned*)(lds + (bufoff) + ldsw + _i * 8192), 16, 0, 0); } while (0)
#define PG8_STAGE_A(bufoff, gbase, h, OFF) do { _Pragma("unroll") for (int _i = 0; _i < 2; ++_i) \
        __builtin_amdgcn_global_load_lds((const unsigned*)((const char*)(gbase) + OFF[h][_i]), (LAS unsigned*)(lds + (bufoff) + ldsw + _i * 8192), 16, 0, 0); } while (0)
#define PG8_LD8(p) __builtin_shufflevector(*(const LAS v4i*)(p), *(const LAS v4i*)((p) + 1024), 0, 1, 2, 3, 4, 5, 6, 7)
#define PG8_LDA(dst, b, h, xo) do { _Pragma("unroll") for (int m = 0; m < 4; ++m) dst[m] = PG8_LD8(lds + (xo) + PG8_SA(b, h) + aoff + m * 2048); } while (0)
#define PG8_LDB(dst, b, h, xo) do { _Pragma("unroll") for (int n = 0; n < 2; ++n) dst[n] = PG8_LD8(lds + (xo) + PG8_SB(b, h) + boff + n * 2048); } while (0)
#define PG8_LO(x) __builtin_bit_cast(bf16x8, __builtin_shufflevector(x, x, 0, 1, 2, 3))
#define PG8_HI(x) __builtin_bit_cast(bf16x8, __builtin_shufflevector(x, x, 4, 5, 6, 7))
#define PG8_MMA(ai, bj, At, Bt) do { __builtin_amdgcn_s_setprio(1); if constexpr (FP8) { _Pragma("unroll") for (int m = 0; m < 4; ++m) _Pragma("unroll") for (int n = 0; n < 2; ++n) \
        acc[ai][bj][m][n] = __builtin_amdgcn_mfma_scale_f32_16x16x128_f8f6f4(Bt[n], At[m], acc[ai][bj][m][n], 0, 0, 0, 0, 0, 0); } \
      else { _Pragma("unroll") for (int m = 0; m < 4; ++m) _Pragma("unroll") for (int n = 0; n < 2; ++n) { \
        acc[ai][bj][m][n] = __builtin_amdgcn_mfma_f32_16x16x32_bf16(PG8_LO(Bt[n]), PG8_LO(At[m]), acc[ai][bj][m][n], 0, 0, 0); \
        acc[ai][bj][m][n] = __builtin_amdgcn_mfma_f32_16x16x32_bf16(PG8_HI(Bt[n]), PG8_HI(At[m]), acc[ai][bj][m][n], 0, 0, 0); } } __builtin_amdgcn_s_setprio(0); } while (0)
#define PG8_WAIT_V(n) asm volatile("s_waitcnt vmcnt(" #n ")" ::: "memory")
#define PG8_WAIT_L(n) asm volatile("s_waitcnt lgkmcnt(" #n ")" ::: "memory")
#define PG8_BAR __builtin_amdgcn_s_barrier()
#define PG8_SCHED __builtin_amdgcn_sched_barrier(0)
#define PG8_GATHER_IDX(U, IDX) do { _Pragma("unroll") for (int _h = 0; _h < 2; ++_h) _Pragma("unroll") for (int _i = 0; _i < 2; ++_i) { int _r = _h * HALF + RA[_i]; \
        _r = _r < (U).nvalid ? _r : (U).nvalid - 1; IDX[_h][_i] = glist[(U).gbase + _r]; } } while (0)
#define PG8_IDX2OFF(IDX, OFF) do { _Pragma("unroll") for (int _h = 0; _h < 2; ++_h) _Pragma("unroll") for (int _i = 0; _i < 2; ++_i) \
        OFF[_h][_i] = (unsigned)IDX[_h][_i] * (unsigned)KB + (unsigned)(CA[_i] * 2); } while (0)
    Unit cur, nxt; int ui = 0;
    if (!S.next(0, cur)) return;
    f32x4 acc[2][2][4][2];
#pragma unroll
    for (int a = 0; a < 2; ++a)
#pragma unroll
        for (int b = 0; b < 2; ++b)
#pragma unroll
            for (int m = 0; m < 4; ++m)
#pragma unroll
                for (int n = 0; n < 2; ++n) acc[a][b][m][n] = (f32x4){0.f, 0.f, 0.f, 0.f};
    v8i At[4], B0[2], B1[2];
    const char* cA = cur.aBase; const char* cB = cur.bBase;
    int nidx[2][2] = {{0, 0}, {0, 0}};
    if constexpr (GATHER) { PG8_GATHER_IDX(cur, nidx); PG8_IDX2OFF(nidx, voffA); }
    PG8_STAGE_B(PG8_SB(0, 0), cB); PG8_STAGE_B(PG8_SB(0, 1), cB + hstep); PG8_STAGE_A(PG8_SA(0, 0), cA, 0, voffA); PG8_STAGE_A(PG8_SA(0, 1), cA, 1, voffA);
    if (wr == 1) PG8_BAR;
    PG8_WAIT_V(2); PG8_BAR;
    PG8_STAGE_B(PG8_SB(1, 0), cB + kstep); PG8_STAGE_A(PG8_SA(1, 0), cA + kstep, 0, voffA); PG8_STAGE_B(PG8_SB(1, 1), cB + hstep + kstep);
    PG8_WAIT_V(6); PG8_BAR;
    for (;;) {
        const bool has_next = S.next(ui + 1, nxt);
        const char* nA = has_next ? nxt.aBase : cA; const char* nB = has_next ? nxt.bBase : cB;
        if constexpr (GATHER) { if (has_next) { PG8_GATHER_IDX(nxt, nidx); } }
        if constexpr (FP8 || ROLL_ALL) {
#pragma unroll 1
        for (int t = 0; t < nt; ++t) {
            const int bo = (t & 1) * 2 * HTB, no = 2 * HTB - bo;
            const bool l1 = (t + 1 >= nt), l2 = (t + 2 >= nt);
            const char* a1 = l1 ? nA + (size_t)(t + 1 - nt) * kstep : cA + (size_t)(t + 1) * kstep;
            const char* a2 = l2 ? nA + (size_t)(t + 2 - nt) * kstep : cA + (size_t)(t + 2) * kstep;
            const char* b2 = l2 ? nB + (size_t)(t + 2 - nt) * kstep : cB + (size_t)(t + 2) * kstep;
            unsigned o1[2][2], o2[2][2];
#pragma unroll
            for (int h = 0; h < 2; ++h)
#pragma unroll
                for (int i = 0; i < 2; ++i) { o1[h][i] = voffA[h][i]; o2[h][i] = voffA[h][i]; }
            if (GATHER && l2) {
                if (has_next) { asm volatile("" : "+v"(nidx[0][0]), "+v"(nidx[0][1]), "+v"(nidx[1][0]), "+v"(nidx[1][1]));
                    PG8_IDX2OFF(nidx, nvoffA); }
#pragma unroll
                for (int h = 0; h < 2; ++h)
#pragma unroll
                    for (int i = 0; i < 2; ++i) { o2[h][i] = nvoffA[h][i]; if (l1) o1[h][i] = nvoffA[h][i]; } }
            PG8_LDB(B0, 0, 0, bo); PG8_LDB(B1, 0, 1, bo); PG8_SCHED; PG8_LDA(At, 0, 0, bo); PG8_STAGE_A(no + PG8_SA(0, 1), a1, 1, o1);
            PG8_WAIT_V(8); PG8_WAIT_L(0); PG8_BAR; PG8_MMA(0, 0, At, B0); PG8_MMA(0, 1, At, B1); PG8_BAR; PG8_SCHED;
            PG8_LDA(At, 0, 1, bo); PG8_STAGE_B(bo + PG8_SB(0, 0), b2); PG8_STAGE_B(bo + PG8_SB(0, 1), b2 + hstep); PG8_STAGE_A(bo + PG8_SA(0, 0), a2, 0, o2);
            PG8_WAIT_V(8); PG8_WAIT_L(0); PG8_BAR; PG8_MMA(1, 0, At, B0); PG8_MMA(1, 1, At, B1); PG8_BAR; PG8_SCHED;
        }
        } else {
#pragma unroll 1
        for (int t = 0; t < nt; t += 2) {
            const bool last = (t == nt - 2);
            const char* a1 = cA + (size_t)(t + 1) * kstep;
            const char* a2 = last ? nA : cA + (size_t)(t + 2) * kstep; const char* b2 = last ? nB : cB + (size_t)(t + 2) * kstep;
            const char* a3 = a2 + kstep; const char* b3 = b2 + kstep;
            unsigned oa[2][2];
#pragma unroll
            for (int h = 0; h < 2; ++h)
#pragma unroll
                for (int i = 0; i < 2; ++i) oa[h][i] = (GATHER && last) ? nvoffA[h][i] : voffA[h][i];
            PG8_LDB(B0, 0, 0, 0); PG8_LDB(B1, 0, 1, 0); PG8_SCHED; PG8_LDA(At, 0, 0, 0); PG8_STAGE_A(PG8_SA(1, 1), a1, 1, voffA);
            PG8_WAIT_V(8); PG8_WAIT_L(0); PG8_BAR; PG8_MMA(0, 0, At, B0); PG8_MMA(0, 1, At, B1); PG8_BAR; PG8_SCHED;
            PG8_LDA(At, 0, 1, 0); PG8_STAGE_B(PG8_SB(0, 0), b2); PG8_STAGE_B(PG8_SB(0, 1), b2 + hstep); PG8_STAGE_A(PG8_SA(0, 0), a2, 0, oa);
            PG8_WAIT_V(8); PG8_WAIT_L(0); PG8_BAR; PG8_MMA(1, 0, At, B0); PG8_MMA(1, 1, At, B1); PG8_BAR; PG8_SCHED;
            PG8_LDB(B0, 1, 0, 0); PG8_LDB(B1, 1, 1, 0); PG8_SCHED; PG8_LDA(At, 1, 0, 0); PG8_STAGE_A(PG8_SA(0, 1), a2, 1, oa);
            PG8_WAIT_V(8); PG8_WAIT_L(0); PG8_BAR; PG8_MMA(0, 0, At, B0); PG8_MMA(0, 1, At, B1); PG8_BAR; PG8_SCHED;
            PG8_LDA(At, 1, 1, 0); PG8_STAGE_B(PG8_SB(1, 0), b3); PG8_STAGE_B(PG8_SB(1, 1), b3 + hstep); PG8_STAGE_A(PG8_SA(1, 0), a3, 0, oa);
            PG8_WAIT_V(8); PG8_WAIT_L(0); PG8_BAR; PG8_MMA(1, 0, At, B0); PG8_MMA(1, 1, At, B1); PG8_BAR; PG8_SCHED;
        }
        }
        if (wr == 0) PG8_BAR;
        { int tz = threadIdx.x; asm volatile("" : "+v"(tz));
          E(acc, cur, wr, wc, tz & 15, (tz & 63) >> 4); }
        if (!has_next) break;
#pragma unroll
        for (int a = 0; a < 2; ++a)
#pragma unroll
            for (int b = 0; b < 2; ++b)
#pragma unroll
                for (int m = 0; m < 4; ++m)
#pragma unroll
                    for (int n = 0; n < 2; ++n) acc[a][b][m][n] = (f32x4){0.f, 0.f, 0.f, 0.f};
        cur = nxt; cA = nA; cB = nB; ++ui;
        if constexpr (GATHER) {
#pragma unroll
            for (int h = 0; h < 2; ++h)
#pragma unroll
                for (int i = 0; i < 2; ++i) voffA[h][i] = nvoffA[h][i]; }
        if (wr == 1) PG8_BAR;
    }
    PG8_WAIT_V(0);
    PG8_BAR;
#undef PG8_SA
#undef PG8_SB
#undef PG8_STAGE_A
#undef PG8_STAGE_B
#undef PG8_LDA
#undef PG8_LDB
#undef PG8_MMA
#undef PG8_LD8
#undef PG8_LO
#undef PG8_HI
#undef PG8_WAIT_V
#undef PG8_WAIT_L
#undef PG8_BAR
#undef PG8_SCHED
#undef PG8_GATHER_IDX
#undef PG8_IDX2OFF
}

struct EpiBf16 {
    static constexpr bool PERM = true;
    bf16* O; int ldc; int prod0;
    __device__ __forceinline__ void operator()(const f32x4 (&acc)[2][2][4][2], const Unit& u, int wr, int wc, int fr, int fq) const {
        const int row0 = u.row0 + wr * 64 + fr;
        if (u.col0 >= prod0) {
            const int col0 = prod0 + ((u.col0 - prod0) >> 1) + wc * 32 + 8 * fq;
#pragma unroll
            for (int ai = 0; ai < 2; ++ai)
#pragma unroll
                for (int m = 0; m < 4; ++m) { const f32x4 v0 = acc[ai][0][m][0] * acc[ai][1][m][0], v1 = acc[ai][0][m][1] * acc[ai][1][m][1];
                    v4u w; w.x = cvt_pk_bf16(v0[0], v0[1]); w.y = cvt_pk_bf16(v0[2], v0[3]); w.z = cvt_pk_bf16(v1[0], v1[1]); w.w = cvt_pk_bf16(v1[2], v1[3]);
                    *(v4u*)(O + (size_t)(row0 + ai * HALF + m * 16) * ldc + col0) = w; }
        } else {
            const int col0 = u.col0 + wc * 32 + 8 * fq;
#pragma unroll
            for (int ai = 0; ai < 2; ++ai)
#pragma unroll
                for (int m = 0; m < 4; ++m) { bf16* rowp = O + (size_t)(row0 + ai * HALF + m * 16) * ldc + col0;
#pragma unroll
                    for (int bj = 0; bj < 2; ++bj) { const f32x4 v0 = acc[ai][bj][m][0], v1 = acc[ai][bj][m][1];
                        v4u w; w.x = cvt_pk_bf16(v0[0], v0[1]); w.y = cvt_pk_bf16(v0[2], v0[3]); w.z = cvt_pk_bf16(v1[0], v1[1]); w.w = cvt_pk_bf16(v1[2], v1[3]);
                        *(v4u*)(rowp + bj * HALF) = w; } }
        }
    }
};
struct EpiResid {
    static constexpr bool PERM = true;
    const float* x; bf16* out; const float* gate;
    float* rowss;
    __device__ __forceinline__ void operator()(const f32x4 (&acc)[2][2][4][2], const Unit& u, int wr, int wc, int fr, int fq) const {
        const int row0 = u.row0 + wr * 64 + fr, col0 = u.col0 + wc * 32 + 8 * fq; const int b = u.row0 / SEQ;
        f32x4 gv[2][2];
#pragma unroll
        for (int bj = 0; bj < 2; ++bj)
#pragma unroll
            for (int n = 0; n < 2; ++n) gv[bj][n] = *(const f32x4*)(gate + (size_t)b * 6 * DM + col0 + bj * HALF + n * 4);
#pragma unroll
        for (int am = 0; am < 4; ++am) {
            const int ai = am >> 1, m0 = (am & 1) * 2;
            f32x4 xv[2][2][2];
#pragma unroll
            for (int mm = 0; mm < 2; ++mm) { const size_t off = (size_t)(row0 + ai * HALF + (m0 + mm) * 16) * DM + col0;
#pragma unroll
                for (int bj = 0; bj < 2; ++bj)
#pragma unroll
                    for (int n = 0; n < 2; ++n) xv[mm][bj][n] = *(const f32x4*)(x + off + bj * HALF + n * 4); }
#pragma unroll
            for (int mm = 0; mm < 2; ++mm) { const int m = m0 + mm; const size_t off = (size_t)(row0 + ai * HALF + m * 16) * DM + col0;
                float ss = 0.f;
#pragma unroll
                for (int bj = 0; bj < 2; ++bj) { const f32x4 o0 = xv[mm][bj][0] + gv[bj][0] * acc[ai][bj][m][0], o1 = xv[mm][bj][1] + gv[bj][1] * acc[ai][bj][m][1];
                    v4u w; w.x = cvt_pk_bf16(o0[0], o0[1]); w.y = cvt_pk_bf16(o0[2], o0[3]); w.z = cvt_pk_bf16(o1[0], o1[1]); w.w = cvt_pk_bf16(o1[2], o1[3]);
                    *(v4u*)(out + off + bj * HALF) = w;
#pragma unroll
                    for (int q = 0; q < 4; ++q) { const float lo = bflo(w[q]), hi = bfhi(w[q]); ss += lo * lo + hi * hi; } }
                ss += __shfl_xor(ss, 16); ss += __shfl_xor(ss, 32);
                if (fq == 0) rowss[(size_t)(row0 + ai * HALF + m * 16) * 32 + (u.col0 >> 8) * 4 + wc] = ss; }
            asm volatile("" ::: "memory"); }
    }
};
struct EpiSwiglu {
    static constexpr bool PERM = true;
    unsigned char* O;
    __device__ __forceinline__ void operator()(const f32x4 (&acc)[2][2][4][2], const Unit& u, int wr, int wc, int fr, int fq) const {
        const int row0 = u.row0 + wr * 64 + fr, col0 = u.col0 + wc * 32 + 8 * fq; constexpr float isc = 1.0f / (F8S_H2 * F8S_W);
#pragma unroll
        for (int ai = 0; ai < 2; ++ai)
#pragma unroll
            for (int m = 0; m < 4; ++m) { unsigned char* rowp = O + (size_t)(row0 + ai * HALF + m * 16) * FF + col0; float o[8];
#pragma unroll
                for (int n = 0; n < 2; ++n)
#pragma unroll
                    for (int j = 0; j < 4; ++j) { const float a = acc[ai][0][m][n][j] * isc, g = acc[ai][1][m][n][j] * (isc * F8S_HID); o[n * 4 + j] = a * fast_sigmoid(a) * g; }
                v2u w; w.x = pack4_fp8(o[0], o[1], o[2], o[3]); w.y = pack4_fp8(o[4], o[5], o[6], o[7]);
                *(v2u*)rowp = w; }
    }
};
struct EpiDown {
    static constexpr bool PERM = true;
    unsigned char* O;
    __device__ __forceinline__ void operator()(const f32x4 (&acc)[2][2][4][2], const Unit& u, int wr, int wc, int fr, int fq) const {
        const int rl0 = wr * 64 + fr, col0 = u.col0 + wc * 32 + 8 * fq; constexpr float gt = F8S_Y / (F8S_HID * F8S_W);
#pragma unroll
        for (int ai = 0; ai < 2; ++ai)
#pragma unroll
            for (int m = 0; m < 4; ++m) { const int rl = rl0 + ai * HALF + m * 16;
                unsigned char* rowp = O + (size_t)(u.row0 + rl) * DM + col0;
#pragma unroll
                for (int bj = 0; bj < 2; ++bj) { const f32x4 v0 = acc[ai][bj][m][0] * gt, v1 = acc[ai][bj][m][1] * gt;
                    v2u w; w.x = pack4_fp8(v0[0], v0[1], v0[2], v0[3]); w.y = pack4_fp8(v1[0], v1[1], v1[2], v1[3]);
                    *(v2u*)(rowp + bj * HALF) = w; } }
    }
};
}

struct Frame {
    LAS unsigned char* lds;
    int tid, lane, wave, vcu, G;
    unsigned char* ws;
    const float *x, *c, *w_ada, *b_ada, *g_mix, *w_in, *lru_conv_w, *lru_conv_b, *lru_w_a, *lru_b_a, *lru_w_x, *lru_b_x, *lru_lambda, *lru_out_g,
                *sc_conv_w, *sc_out_g, *w_out, *g_ffn, *w_rg, *b_rg, *w_re, *b_re, *w1, *w3, *w2, *g_final;
    float* out;
};

__device__ __forceinline__ void phase0(const Frame& F) {
    LAS float* cond = (LAS float*)F.lds;
    LAS float* red = (LAS float*)(F.lds + 32768);
    for (int i = F.tid; i < NB * DM; i += 512) { const float v = F.c[i]; cond[i] = v / (1.0f + __expf(-v)); }
    __syncthreads();
    {
        bf16* wf = (bf16*)(F.ws + WS_WRT);
        for (int i = F.vcu * 512 + F.tid; i < 48 * DM; i += F.G * 512) { const int e = i / DM, k = i % DM;
            const float v = e < 32 ? F.w_re[k * 32 + e] : (e < 36 ? F.w_rg[k * 4 + (e - 32)] : 0.f);
            const unsigned h = f2bf(v); const int t = k >> 5, fq = (k >> 3) & 3, jj = k & 7, n = e >> 4, fr = e & 15;
            const size_t o = ((size_t)((t * 3 + n) * 2) * 64 + fq * 16 + fr) * 8 + jj;
            wf[o] = (bf16)h; wf[o + 512] = (bf16)f2bf(v - bf2f(h)); }
    }
    {
        bf16* wl = (bf16*)(F.ws + WS_WLRU);
        for (int i = F.vcu * 512 + F.tid; i < 4 * 2 * 256 * 256; i += F.G * 512) { const int head = i >> 17, g = (i >> 16) & 1, k = (i >> 8) & 255, j = i & 255;
            const float v = (g ? F.lru_w_x : F.lru_w_a)[(size_t)head * 65536 + k * 256 + j];
            wl[(size_t)((head * 2 + g) * 256 + j) * 256 + k] = (bf16)f2bf(v); }
    }
    {
        LAS float* scr = (LAS float*)(F.lds + 65536 + F.wave * 8704);
        const int gw = F.vcu * 8 + F.wave, NGW = F.G * 8;
        constexpr int I_IN = 32 * 160, I_OUT = 32 * 64, I_13 = NEXP * 32 * 64, I_2 = NEXP * 16 * 64;
        constexpr int NITEMS = I_IN + I_OUT + I_13 + I_2;
        struct TItem { const float* src; unsigned char* dst; int ldw, K, n0d, fp8; };
        auto decode = [&](int it) -> TItem {
            TItem t; int r = it;
            if (r < I_IN) { const int kb = r / 160, nb = r % 160; t.src = F.w_in + (size_t)(kb * 64) * IN_COLS + nb * 32; t.ldw = IN_COLS;
                int nd = nb * 32;
                if (nd >= 3072) { const int tq = (nd - 3072) >> 10, ch = (nd - 3072) & 1023; nd = 3072 + (ch >> 7) * 256 + tq * 128 + (ch & 127); }
                t.dst = F.ws + WS_WIN + ((size_t)nd * DM + kb * 64) * 2; t.K = DM; t.fp8 = 0; return t; } r -= I_IN;
            if (r < I_OUT) { const int kb = r / 64, nb = r % 64; t.src = F.w_out + (size_t)(kb * 64) * DM + nb * 32; t.ldw = DM; t.dst = F.ws + WS_WOUT + ((size_t)(nb * 32) * DM + kb * 64) * 2; t.K = DM; t.fp8 = 0; return t; } r -= I_OUT;
            if (r < I_13) { const int e = r / 2048, q = r % 2048, kb = q / 64, nb = q % 64;
                const int pn = nb >> 3, half = (nb >> 2) & 1, j0 = (nb & 3) * 32;
                t.src = (half ? F.w3 : F.w1) + (size_t)e * DM * FF + (size_t)(kb * 64) * FF + pn * 128 + j0; t.ldw = FF;
                t.dst = F.ws + WS_W13 + (size_t)e * DM * DM + (size_t)(nb * 32) * DM + kb * 64; t.K = DM; t.fp8 = 1; return t; } r -= I_13;
            { const int e = r / 1024, q = r % 1024, kb = q / 64, nb = q % 64;
                t.src = F.w2 + (size_t)e * FF * DM + (size_t)(kb * 64) * DM + nb * 32; t.ldw = DM; t.dst = F.ws + WS_W2 + (size_t)e * DM * FF + (size_t)(nb * 32) * FF + kb * 64; t.K = FF; t.fp8 = 1; return t; }
        };
        const int cq = F.tid % 12, kg = F.tid / 12; const bool modt = (kg < 42) && (F.vcu < 256);
        const float* wada = F.w_ada + (size_t)(F.vcu < 256 ? F.vcu : 0) * 48 + 4 * cq;
        f32x4 a0 = {0, 0, 0, 0}, a1 = a0, a2 = a0, a3 = a0, wcur = a0, wnext = a0; int kpos = kg;
        if (modt) wcur = *(const f32x4*)(wada + (size_t)kpos * (6 * DM));
        f32x4 cur[8], nxt[8];
        int it = gw; TItem ti{};
        if (it < NITEMS) { ti = decode(it);
#pragma unroll
            for (int i = 0; i < 8; ++i) cur[i] = __builtin_nontemporal_load((const f32x4*)(ti.src + (size_t)(8 * i + (F.lane >> 3)) * ti.ldw + 4 * (F.lane & 7))); }
        for (; it < NITEMS; it += NGW) {
            const int itn = it + NGW; TItem tn = ti;
            const bool mnext = modt && (kpos + 42 < DM);
            if (mnext) wnext = *(const f32x4*)(wada + (size_t)(kpos + 42) * (6 * DM));
            if (itn < NITEMS) { tn = decode(itn);
#pragma unroll
                for (int i = 0; i < 8; ++i) nxt[i] = __builtin_nontemporal_load((const f32x4*)(tn.src + (size_t)(8 * i + (F.lane >> 3)) * tn.ldw + 4 * (F.lane & 7))); }
#pragma unroll
            for (int i = 0; i < 8; ++i) { LAS float* sw = scr + (8 * i + (F.lane >> 3)) * 33 + 4 * (F.lane & 7); sw[0] = cur[i].x; sw[1] = cur[i].y; sw[2] = cur[i].z; sw[3] = cur[i].w; }
            LDS_WAIT(); asm volatile("" ::: "memory");
            if (ti.fp8) { const int c = F.lane & 3;
#pragma unroll
                for (int j = 0; j < 2; ++j) { const int n = (F.lane >> 2) + 16 * j; const LAS float* sp = scr + (16 * c) * 33 + n; v4u o;
#pragma unroll
                    for (int q = 0; q < 4; ++q) o[q] = pack4_fp8(sp[(4 * q) * 33] * F8S_W, sp[(4 * q + 1) * 33] * F8S_W, sp[(4 * q + 2) * 33] * F8S_W, sp[(4 * q + 3) * 33] * F8S_W);
                    __builtin_nontemporal_store(o, (v4u*)(ti.dst + (size_t)n * ti.K + 16 * c)); }
            } else { const int c = F.lane & 7;
#pragma unroll
                for (int j = 0; j < 4; ++j) { const int n = (F.lane >> 3) + 8 * j; const LAS float* sp = scr + (8 * c) * 33 + n;
                    v4u o; o.x = pk2(sp[0 * 33], sp[1 * 33]); o.y = pk2(sp[2 * 33], sp[3 * 33]); o.z = pk2(sp[4 * 33], sp[5 * 33]); o.w = pk2(sp[6 * 33], sp[7 * 33]);
                    *(v4u*)(ti.dst + ((size_t)n * ti.K + 8 * c) * 2) = o; } }
            LDS_WAIT(); asm volatile("" ::: "memory");
            ti = tn;
#pragma unroll
            for (int i = 0; i < 8; ++i) cur[i] = nxt[i];
            if (modt && kpos < DM) { a0 += wcur * cond[kpos]; a1 += wcur * cond[DM + kpos]; a2 += wcur * cond[2 * DM + kpos]; a3 += wcur * cond[3 * DM + kpos]; kpos += 42; wcur = wnext; }
        }
        if (modt) { for (; kpos < DM; kpos += 42) { const f32x4 w = *(const f32x4*)(wada + (size_t)kpos * (6 * DM));
                a0 += w * cond[kpos]; a1 += w * cond[DM + kpos]; a2 += w * cond[2 * DM + kpos]; a3 += w * cond[3 * DM + kpos]; }
            LAS float* r = red + kg * 192 + cq * 4;
#pragma unroll
            for (int j = 0; j < 4; ++j) { r[j] = a0[j]; r[48 + j] = a1[j]; r[96 + j] = a2[j]; r[144 + j] = a3[j]; } }
        __syncthreads();
        if (F.tid < 192 && F.vcu < 256) { float sm = 0.f; for (int g = 0; g < 42; ++g) sm += red[g * 192 + F.tid]; const int bb = F.tid / 48, cc = F.tid % 48;
            ((float*)(F.ws + WS_MOD))[bb * 6 * DM + F.vcu * 48 + cc] = sm + F.b_ada[F.vcu * 48 + cc]; }
        for (int chunk = F.vcu + F.G; chunk < 256; chunk += F.G) {
            __syncthreads();
            const int col0 = chunk * 48; f32x4 b0 = {0, 0, 0, 0}, b1 = b0, b2 = b0, b3 = b0;
            if (kg < 42) { for (int k = kg; k < DM; k += 42) { const f32x4 w = *(const f32x4*)(F.w_ada + (size_t)k * (6 * DM) + col0 + 4 * cq);
                    b0 += w * cond[k]; b1 += w * cond[DM + k]; b2 += w * cond[2 * DM + k]; b3 += w * cond[3 * DM + k]; }
                LAS float* r = red + kg * 192 + cq * 4;
#pragma unroll
                for (int j = 0; j < 4; ++j) { r[j] = b0[j]; r[48 + j] = b1[j]; r[96 + j] = b2[j]; r[144 + j] = b3[j]; } }
            __syncthreads();
            if (F.tid < 192) { float sm = 0.f; for (int g = 0; g < 42; ++g) sm += red[g * 192 + F.tid]; const int bb = F.tid / 48, cc = F.tid % 48;
                ((float*)(F.ws + WS_MOD))[bb * 6 * DM + col0 + cc] = sm + F.b_ada[col0 + cc]; }
        }
    }
}

__device__ __forceinline__ void norm_rows(const Frame& F, const float* xin, const float* gain, const float* mod_sh, const float* mod_sc, bf16* outp, int row_begin, int nrows, LAS float* rstd_lds, bool want_rstd) {
    const int b = row_begin / SEQ;
    f32x4 gs[8], sh[8];
#pragma unroll
    for (int j = 0; j < 8; ++j) { const int c = 4 * F.lane + 256 * j; const f32x4 g = *(const f32x4*)(gain + c), s = *(const f32x4*)(mod_sc + (size_t)b * 6 * DM + c);
        gs[j] = g * (s + 1.0f); sh[j] = *(const f32x4*)(mod_sh + (size_t)b * 6 * DM + c); }
    f32x4 va[8], vb[8], na[8], nb_[8];
    { const f32x4* x0 = (const f32x4*)(xin + (size_t)row_begin * DM) + F.lane; const f32x4* x1p = x0 + DM / 4;
#pragma unroll
      for (int j = 0; j < 8; ++j) { va[j] = __builtin_nontemporal_load(x0 + 64 * j); vb[j] = __builtin_nontemporal_load(x1p + 64 * j); } }
#pragma unroll 1
    for (int r = 0; r < nrows; r += 2) {
        const int row = row_begin + r; const int rn = (r + 2 < nrows) ? row + 2 : row;
        { const f32x4* x0 = (const f32x4*)(xin + (size_t)rn * DM) + F.lane; const f32x4* x1p = x0 + DM / 4;
#pragma unroll
          for (int j = 0; j < 8; ++j) { na[j] = __builtin_nontemporal_load(x0 + 64 * j); nb_[j] = __builtin_nontemporal_load(x1p + 64 * j); } }
        float s0 = 0.f, s1 = 0.f;
#pragma unroll
        for (int j = 0; j < 8; ++j) { s0 += (va[j].x * va[j].x + va[j].y * va[j].y) + (va[j].z * va[j].z + va[j].w * va[j].w); s1 += (vb[j].x * vb[j].x + vb[j].y * vb[j].y) + (vb[j].z * vb[j].z + vb[j].w * vb[j].w); }
        const float rstd0 = 1.0f / sqrtf(wave_sum(s0) * (1.0f / DM) + EPS), rstd1 = 1.0f / sqrtf(wave_sum(s1) * (1.0f / DM) + EPS);
        if (want_rstd && F.lane == 0) { rstd_lds[r] = rstd0; rstd_lds[r + 1] = rstd1; }
        v2u* o8 = (v2u*)(outp + (size_t)row * DM) + F.lane;
#pragma unroll
        for (int j = 0; j < 8; ++j) { const f32x4 h0 = va[j] * rstd0 * gs[j] + sh[j], h1 = vb[j] * rstd1 * gs[j] + sh[j]; v2u w0, w1; w0.x = pk2(h0.x, h0.y); w0.y = pk2(h0.z, h0.w); w1.x = pk2(h1.x, h1.y); w1.y = pk2(h1.z, h1.w);
            o8[64 * j] = w0; o8[DM / 4 + 64 * j] = w1; }
#pragma unroll
        for (int j = 0; j < 8; ++j) { va[j] = na[j]; vb[j] = nb_[j]; }
    }
}

__device__ __forceinline__ void sconv_phase(const Frame& F, int first_round) {
    const bf16* proj = (const bf16*)(F.ws + WS_PROJ); bf16* ycat = (bf16*)(F.ws + WS_YCAT);
    const int gw = F.vcu * 8 + F.wave, NGW = F.G * 8;
    const int cb = F.lane & 15, q = F.lane >> 4;
    for (int wu = gw + first_round * NGW; wu < 8 * 256; wu += NGW) {
        const int g = (wu & 1) * 4 + q, ck = wu >> 1; const int c0 = g * 128 + cb * 8;
        float w0[8], w1[8], w2[8], gn[8];
#pragma unroll
        for (int j = 0; j < 8; ++j) { w0[j] = F.sc_conv_w[c0 + j]; w1[j] = F.sc_conv_w[SC_W + c0 + j]; w2[j] = F.sc_conv_w[2 * SC_W + c0 + j]; gn[j] = F.sc_out_g[c0 + j]; }
        const int r_s = ck * 32; const int t_s = r_s % SEQ; const int pc0 = 2048 + c0;
        float p1[8], p2[8];
#pragma unroll
        for (int j = 0; j < 8; ++j) { p1[j] = 0.f; p2[j] = 0.f; }
        if (t_s >= 1) { const v4u cv = *(const v4u*)(proj + (size_t)(r_s - 1) * IN_COLS + pc0 + 1024);
#pragma unroll
            for (int j = 0; j < 4; ++j) { p1[2 * j] = bflo(cv[j]); p1[2 * j + 1] = bfhi(cv[j]); } }
        if (t_s >= 2) { const v4u cv = *(const v4u*)(proj + (size_t)(r_s - 2) * IN_COLS + pc0 + 1024);
#pragma unroll
            for (int j = 0; j < 4; ++j) { p2[2 * j] = bflo(cv[j]); p2[2 * j + 1] = bfhi(cv[j]); } }
#pragma unroll 2
        for (int i = 0; i < 32; ++i) {
            const size_t ro = (size_t)(r_s + i) * IN_COLS + pc0;
            const v4u bv = *(const v4u*)(proj + ro), cv = *(const v4u*)(proj + ro + 1024);
            float y[8]; float ss = 0.f;
#pragma unroll
            for (int j = 0; j < 4; ++j) {
                const float pa = bflo(cv[j]), pb = bfhi(cv[j]);
                y[2 * j] = bflo(bv[j]) * (w0[2 * j] * p2[2 * j] + w1[2 * j] * p1[2 * j] + w2[2 * j] * pa);
                y[2 * j + 1] = bfhi(bv[j]) * (w0[2 * j + 1] * p2[2 * j + 1] + w1[2 * j + 1] * p1[2 * j + 1] + w2[2 * j + 1] * pb);
                p2[2 * j] = p1[2 * j]; p2[2 * j + 1] = p1[2 * j + 1]; p1[2 * j] = pa; p1[2 * j + 1] = pb;
                ss += y[2 * j] * y[2 * j] + y[2 * j + 1] * y[2 * j + 1]; }
            ss += __shfl_xor(ss, 1); ss += __shfl_xor(ss, 2); ss += __shfl_xor(ss, 4); ss += __shfl_xor(ss, 8);
            const float rstd = 1.0f / sqrtf(ss * (1.0f / 128.0f) + EPS);
            v4u o;
#pragma unroll
            for (int j = 0; j < 4; ++j) o[j] = pk2(y[2 * j] * rstd * gn[2 * j], y[2 * j + 1] * rstd * gn[2 * j + 1]);
            *(v4u*)(ycat + (size_t)(r_s + i) * DM + 1024 + c0) = o;
        }
    }
}

constexpr int LRU_T = 128;
constexpr int LRU_XC = 0;
constexpr int LRU_G = 65536;
constexpr int LRU_PS = LRU_G + 128 * 528;
constexpr int LRU_HIN = LRU_PS + 4096;
constexpr int LRU_RS = LRU_HIN + 1024;
constexpr int LRU_HIN2 = LRU_RS + 512;
__device__ __forceinline__ int xc_off(int r, int c) { const int st = (r >> 4) * 8 + (c >> 5), ob = (r & 15) * 64 + (c & 31) * 2; return st * 1024 + (ob ^ (((ob >> 9) & 1) << 5)); }

template <bool FINAL>
__device__ __forceinline__ void lru_phase(const Frame& F) {
    const bf16* proj = (const bf16*)(F.ws + WS_PROJ); bf16* ycat = (bf16*)(F.ws + WS_YCAT); f32x2* car = (f32x2*)(F.ws + WS_CAR);
    v4u* au = (v4u*)(F.ws + WS_H);
    LAS unsigned char* lds = F.lds;
    bf16x8 Bw[2][2][8]; float ba[2] = {0.f, 0.f}, bx[2] = {0.f, 0.f}, cneg[2] = {0.f, 0.f}; int cur_head = -1;
#pragma unroll
    for (int g = 0; g < 2; ++g)
#pragma unroll
        for (int n = 0; n < 2; ++n)
#pragma unroll
            for (int kk = 0; kk < 8; ++kk) Bw[g][n][kk] = (bf16x8){0, 0, 0, 0, 0, 0, 0, 0};
#pragma unroll 1
    for (int u = F.vcu; u < 1024; u += F.G) {
        const int head = u & 3, bt = u >> 2, b = bt >> 6, tt = bt & 63;
        int tz = threadIdx.x; asm volatile("" : "+v"(tz));
        const int tid = tz, lane = tz & 63, fr = lane & 15, fq = lane >> 4;
        const int rowbase = b * SEQ + tt * LRU_T;
        if (FINAL) {
            const int half = tid >> 8, ch = tid & 255; const int n0 = (tt + 1) >> 1; const int kbeg = half ? n0 : 0, cnt = half ? (tt - n0) : n0;
            const f32x2* cp = car + (size_t)(b * 64) * LRU_W + head * LRU_HD + ch; f32x2 v[32];
#pragma unroll
            for (int q = 0; q < 32; ++q) { int k = kbeg + q; k = k > 63 ? 63 : k; v[q] = cp[(size_t)k * LRU_W]; }
            float A = 1.f, H = 0.f;
#pragma unroll
            for (int q = 0; q < 32; ++q) { const float a = q < cnt ? v[q].x : 1.f, hh = q < cnt ? v[q].y : 0.f; H = a * H + hh; A = a * A; }
            if (half == 0) ((LAS float*)(lds + LRU_HIN))[ch] = H; else { ((LAS float*)(lds + LRU_HIN2))[ch] = A; ((LAS float*)(lds + LRU_HIN2))[256 + ch] = H; }
        }
        {
            const int cb = tid & 31, rr = tid >> 5; const int c0 = head * LRU_HD + cb * 8;
            v4u xr[11];
#pragma unroll
            for (int q = 0; q < 11; ++q) { const int t = tt * LRU_T + rr * 8 - 3 + q;
                if (t >= 0) xr[q] = *(const v4u*)(proj + (size_t)(b * SEQ + t) * IN_COLS + c0); else xr[q] = (v4u){0u, 0u, 0u, 0u}; }
            float cw[4][8], cbias[8];
#pragma unroll
            for (int k = 0; k < 4; ++k)
#pragma unroll
                for (int j = 0; j < 8; ++j) cw[k][j] = F.lru_conv_w[k * LRU_W + c0 + j];
#pragma unroll
            for (int j = 0; j < 8; ++j) cbias[j] = F.lru_conv_b[c0 + j];
#pragma unroll
            for (int r = 0; r < 8; ++r) { float o[8];
#pragma unroll
                for (int j = 0; j < 4; ++j) { float lo = cbias[2 * j], hi = cbias[2 * j + 1];
#pragma unroll
                    for (int k = 0; k < 4; ++k) { lo += cw[k][2 * j] * bflo(xr[r + k][j]); hi += cw[k][2 * j + 1] * bfhi(xr[r + k][j]); }
                    o[2 * j] = lo; o[2 * j + 1] = hi; }
                v4u w; w.x = pk2(o[0], o[1]); w.y = pk2(o[2], o[3]); w.z = pk2(o[4], o[5]); w.w = pk2(o[6], o[7]);
                *(LAS v4u*)(lds + LRU_XC + xc_off(rr * 8 + r, cb * 8)) = w; }
        }
        if (FINAL) {
#pragma unroll
            for (int i = 0; i < 8; ++i) { const int p = tid + 512 * i, t = p >> 5, cp = p & 31;
                const v4u v = *(const v4u*)(proj + (size_t)(rowbase + t) * IN_COLS + 1024 + head * LRU_HD + cp * 8);
                *(LAS v4u*)(lds + LRU_G + t * 528 + cp * 16) = v; }
        }
        asm volatile("" ::: "memory"); __builtin_amdgcn_sched_barrier(0);
        if (head != cur_head) { cur_head = head; const bf16* wl = (const bf16*)(F.ws + WS_WLRU);
#pragma unroll
            for (int g = 0; g < 2; ++g)
#pragma unroll
                for (int n = 0; n < 2; ++n) { const bf16* wp = wl + (size_t)((head * 2 + g) * 256 + F.wave * 32 + n * 16 + fr) * 256 + 8 * fq;
#pragma unroll
                    for (int kk = 0; kk < 8; ++kk) Bw[g][n][kk] = *(const bf16x8*)(wp + kk * 32); }
#pragma unroll
            for (int n = 0; n < 2; ++n) { const int ch = head * LRU_HD + F.wave * 32 + n * 16 + fr; ba[n] = F.lru_b_a[ch]; bx[n] = F.lru_b_x[ch];
                cneg[n] = -8.0f * log1pf(expf(-F.lru_lambda[ch])) * 1.4426950408889634f; }
        }
        __syncthreads();
        float hc[2], At_[2], Ht_[2];
#pragma unroll
        for (int n = 0; n < 2; ++n) { { const int jj = F.wave * 32 + n * 16 + fr; hc[n] = FINAL ? ((LAS float*)(lds + LRU_HIN2))[jj] * ((LAS float*)(lds + LRU_HIN))[jj] + ((LAS float*)(lds + LRU_HIN2))[256 + jj] : 0.f; } At_[n] = 1.f; Ht_[n] = 0.f; }
#pragma unroll 1
        for (int m = 0; m < 8; ++m) {
            f32x4 acc[2][2];
#pragma unroll
            for (int g = 0; g < 2; ++g)
#pragma unroll
                for (int n = 0; n < 2; ++n) acc[g][n] = (f32x4){0.f, 0.f, 0.f, 0.f};
#pragma unroll
            for (int kk = 0; kk < 8; ++kk) { const bf16x8 a = *(const LAS bf16x8*)(lds + LRU_XC + xc_off(m * 16 + fr, kk * 32 + fq * 8));
#pragma unroll
                for (int g = 0; g < 2; ++g)
#pragma unroll
                    for (int n = 0; n < 2; ++n) acc[g][n] = __builtin_amdgcn_mfma_f32_16x16x32_bf16(a, Bw[g][n][kk], acc[g][n], 0, 0, 0); }
            float ssq[4] = {0.f, 0.f, 0.f, 0.f};
            __builtin_amdgcn_sched_barrier(0);
#pragma unroll
            for (int n = 0; n < 2; ++n) {
                if (n) __builtin_amdgcn_sched_barrier(0);
                const int j = F.wave * 32 + n * 16 + fr;
                float av[4], uv[4]; v4u aupk;
#pragma unroll
                for (int r = 0; r < 4; ++r) { const int t = m * 16 + 4 * fq + r;
                    const float rg = fast_sigmoid(acc[0][n][r] + ba[n]), ig = fast_sigmoid(acc[1][n][r] + bx[n]);
                    const float l2x = cneg[n] * rg;
                    const float a2 = __builtin_amdgcn_exp2f(2.0f * l2x);
                    const float mult = __builtin_amdgcn_sqrtf(1.0f - a2);
                    const float xcv = bf2f(*(const LAS unsigned short*)(lds + LRU_XC + xc_off(t, j)));
                    const unsigned l2b = f2bf(l2x), ub = f2bf(mult * (ig * xcv));
                    aupk[r] = l2b | (ub << 16);
                    av[r] = __builtin_amdgcn_exp2f(bf2f(l2b)); uv[r] = bf2f(ub); }
                if (!FINAL) au[((size_t)u * 16 + m * 2 + n) * 512 + F.wave * 64 + lane] = aupk;
                float P[4], Q[4]; P[0] = av[0]; Q[0] = uv[0];
#pragma unroll
                for (int r = 1; r < 4; ++r) { Q[r] = av[r] * Q[r - 1] + uv[r]; P[r] = av[r] * P[r - 1]; }
                float TP = P[3], TQ = Q[3];
                { const float pp = __shfl_up(TP, 16), pq = __shfl_up(TQ, 16); if (fq >= 1) { TQ = TP * pq + TQ; TP = TP * pp; } }
                { const float pp = __shfl_up(TP, 32), pq = __shfl_up(TQ, 32); if (fq >= 2) { TQ = TP * pq + TQ; TP = TP * pp; } }
                if (FINAL) {
                    float EP = __shfl_up(TP, 16), EQ = __shfl_up(TQ, 16); if (fq == 0) { EP = 1.f; EQ = 0.f; }
                    const float hin = EP * hc[n] + EQ;
                    const float hnew = TP * hc[n] + TQ;
                    hc[n] = __shfl(hnew, fr + 48);
#pragma unroll
                    for (int r = 0; r < 4; ++r) { const int t = m * 16 + 4 * fq + r; const float h = P[r] * hin + Q[r];
                        LAS unsigned short* gp = (LAS unsigned short*)(lds + LRU_G + t * 528 + j * 2);
                        const float gt = bf2f(*gp);
                        const float y = h * gt * fast_sigmoid(1.5957691216057308f * (gt + 0.044715f * gt * gt * gt));
                        ssq[r] += y * y; *gp = (unsigned short)f2bf(y); }
                } else {
                    const float tP = __shfl(TP, fr + 48), tQ = __shfl(TQ, fr + 48);
                    Ht_[n] = tP * Ht_[n] + tQ; At_[n] = tP * At_[n];
                }
            }
            if (FINAL) {
#pragma unroll
                for (int r = 0; r < 4; ++r) { float s = ssq[r]; s += __shfl_xor(s, 1); s += __shfl_xor(s, 2); s += __shfl_xor(s, 4); s += __shfl_xor(s, 8);
                    if (fr == 0) ((LAS float*)(lds + LRU_PS))[(m * 16 + 4 * fq + r) * 8 + F.wave] = s; }
            }
        }
        if (!FINAL) {
            if (fq == 3) {
#pragma unroll
                for (int n = 0; n < 2; ++n) car[(size_t)(b * 64 + tt) * LRU_W + head * LRU_HD + F.wave * 32 + n * 16 + fr] = (f32x2){At_[n], Ht_[n]};
            }
        } else {
            __syncthreads();
            if (tid < 128) { const LAS float* ps = (const LAS float*)(lds + LRU_PS) + tid * 8; float s = 0.f;
#pragma unroll
                for (int w = 0; w < 8; ++w) s += ps[w];
                ((LAS float*)(lds + LRU_RS))[tid] = 1.0f / sqrtf(s * (1.0f / LRU_HD) + EPS); }
            __syncthreads();
#pragma unroll
            for (int i = 0; i < 8; ++i) { const int p = tid + 512 * i, t = p >> 5, cp = p & 31;
                const v4u v = *(const LAS v4u*)(lds + LRU_G + t * 528 + cp * 16); const float rs = ((const LAS float*)(lds + LRU_RS))[t];
                const float* gp = F.lru_out_g + head * LRU_HD + cp * 8; v4u o;
#pragma unroll
                for (int jx = 0; jx < 4; ++jx) o[jx] = pk2(bflo(v[jx]) * rs * gp[2 * jx], bfhi(v[jx]) * rs * gp[2 * jx + 1]);
                *(v4u*)(ycat + (size_t)(rowbase + t) * DM + head * LRU_HD + cp * 8) = o; }
        }
        __syncthreads();
    }
}

__device__ __forceinline__ void lru_final_phase(const Frame& F) {
    const bf16* proj = (const bf16*)(F.ws + WS_PROJ); bf16* ycat = (bf16*)(F.ws + WS_YCAT); const f32x2* car = (const f32x2*)(F.ws + WS_CAR);
    const v4u* au = (const v4u*)(F.ws + WS_H);
    LAS unsigned char* lds = F.lds;
    const int sc_wu = F.vcu * 8 + F.wave; const bool sc_on = sc_wu < 8 * 256;
    const int sc_cb = F.lane & 15, sc_g = (sc_wu & 1) * 4 + (F.lane >> 4), sc_c0 = sc_g * 128 + sc_cb * 8, sc_rs = (sc_on ? (sc_wu >> 1) : 0) * 32, sc_pc0 = 2048 + sc_c0;
    float sw0[8], sw1[8], sw2[8], sgn[8], sp1[8], sp2[8]; v4u sbb, scc, snb, snc; int sc_i = 0;
#pragma unroll
    for (int j = 0; j < 8; ++j) { sw0[j] = F.sc_conv_w[sc_c0 + j]; sw1[j] = F.sc_conv_w[SC_W + sc_c0 + j]; sw2[j] = F.sc_conv_w[2 * SC_W + sc_c0 + j]; sgn[j] = F.sc_out_g[sc_c0 + j]; sp1[j] = 0.f; sp2[j] = 0.f; }
    { const int t_s = sc_rs % SEQ; const int r1 = t_s >= 1 ? sc_rs - 1 : sc_rs, r2 = t_s >= 2 ? sc_rs - 2 : sc_rs;
      const v4u q1 = *(const v4u*)(proj + (size_t)r1 * IN_COLS + sc_pc0 + 1024), q2 = *(const v4u*)(proj + (size_t)r2 * IN_COLS + sc_pc0 + 1024);
#pragma unroll
      for (int j = 0; j < 4; ++j) { sp1[2 * j] = t_s >= 1 ? bflo(q1[j]) : 0.f; sp1[2 * j + 1] = t_s >= 1 ? bfhi(q1[j]) : 0.f;
                                    sp2[2 * j] = t_s >= 2 ? bflo(q2[j]) : 0.f; sp2[2 * j + 1] = t_s >= 2 ? bfhi(q2[j]) : 0.f; } }
    { const size_t ro = (size_t)sc_rs * IN_COLS + sc_pc0; sbb = *(const v4u*)(proj + ro); scc = *(const v4u*)(proj + ro + 1024); snb = sbb; snc = scc; }
    auto sc_prefetch = [&]() { if (sc_on && sc_i + 1 < 32) { const size_t ro = (size_t)(sc_rs + sc_i + 1) * IN_COLS + sc_pc0; snb = *(const v4u*)(proj + ro); snc = *(const v4u*)(proj + ro + 1024); } };
    auto sc_step = [&]() { if (sc_on && sc_i < 32) {
            float y[8]; float ss = 0.f;
#pragma unroll
            for (int j = 0; j < 4; ++j) {
                const float pa = bflo(scc[j]), pb = bfhi(scc[j]);
                y[2 * j] = bflo(sbb[j]) * (sw0[2 * j] * sp2[2 * j] + sw1[2 * j] * sp1[2 * j] + sw2[2 * j] * pa);
                y[2 * j + 1] = bfhi(sbb[j]) * (sw0[2 * j + 1] * sp2[2 * j + 1] + sw1[2 * j + 1] * sp1[2 * j + 1] + sw2[2 * j + 1] * pb);
                sp2[2 * j] = sp1[2 * j]; sp2[2 * j + 1] = sp1[2 * j + 1]; sp1[2 * j] = pa; sp1[2 * j + 1] = pb;
                ss += y[2 * j] * y[2 * j] + y[2 * j + 1] * y[2 * j + 1]; }
            ss += __shfl_xor(ss, 1); ss += __shfl_xor(ss, 2); ss += __shfl_xor(ss, 4); ss += __shfl_xor(ss, 8);
            const float rstd = 1.0f / sqrtf(ss * (1.0f / 128.0f) + EPS);
            v4u o;
#pragma unroll
            for (int j = 0; j < 4; ++j) o[j] = pk2(y[2 * j] * rstd * sgn[2 * j], y[2 * j + 1] * rstd * sgn[2 * j + 1]);
            *(v4u*)(ycat + (size_t)(sc_rs + sc_i) * DM + 1024 + sc_c0) = o;
            sbb = snb; scc = snc; ++sc_i; } };
#pragma unroll 1
    for (int u = F.vcu; u < 1024; u += F.G) {
        const int head = u & 3, bt = u >> 2, b = bt >> 6, tt = bt & 63;
        int tz = threadIdx.x; asm volatile("" : "+v"(tz));
        const int tid = tz, lane = tz & 63, fr = lane & 15, fq = lane >> 4;
        const int rowbase = b * SEQ + tt * LRU_T;
        v4u aub[8][2];
#pragma unroll
        for (int m = 0; m < 8; ++m)
#pragma unroll
            for (int n = 0; n < 2; ++n) aub[m][n] = au[((size_t)u * 16 + m * 2 + n) * 512 + F.wave * 64 + lane];
        { const int half = tid >> 8, ch = tid & 255; const int n0 = (tt + 1) >> 1; const int kbeg = half ? n0 : 0, cnt = half ? (tt - n0) : n0;
            const f32x2* cp = car + (size_t)(b * 64) * LRU_W + head * LRU_HD + ch; f32x2 v[32];
#pragma unroll
            for (int q = 0; q < 32; ++q) { int k = kbeg + q; k = k > 63 ? 63 : k; v[q] = cp[(size_t)k * LRU_W]; }
            float A = 1.f, H = 0.f;
#pragma unroll
            for (int q = 0; q < 32; ++q) { const float a = q < cnt ? v[q].x : 1.f, hh = q < cnt ? v[q].y : 0.f; H = a * H + hh; A = a * A; }
            if (half == 0) ((LAS float*)(lds + LRU_HIN))[ch] = H; else { ((LAS float*)(lds + LRU_HIN2))[ch] = A; ((LAS float*)(lds + LRU_HIN2))[256 + ch] = H; } }
#pragma unroll
        for (int i = 0; i < 8; ++i) { const int p = tid + 512 * i, t = p >> 5, cp = p & 31;
            const v4u v = *(const v4u*)(proj + (size_t)(rowbase + t) * IN_COLS + 1024 + head * LRU_HD + cp * 8);
            *(LAS v4u*)(lds + LRU_G + t * 528 + cp * 16) = v; }
        __syncthreads();
        float hc[2];
#pragma unroll
        for (int n = 0; n < 2; ++n) { const int jj = F.wave * 32 + n * 16 + fr; hc[n] = ((LAS float*)(lds + LRU_HIN2))[jj] * ((LAS float*)(lds + LRU_HIN))[jj] + ((LAS float*)(lds + LRU_HIN2))[256 + jj]; }
#pragma unroll
        for (int m = 0; m < 8; ++m) {
            sc_prefetch();
            float ssq[4] = {0.f, 0.f, 0.f, 0.f};
#pragma unroll
            for (int n = 0; n < 2; ++n) {
                const int j = F.wave * 32 + n * 16 + fr;
                float P[4], Q[4];
                { const float a0 = __builtin_amdgcn_exp2f(bflo(aub[m][n][0])); P[0] = a0; Q[0] = bfhi(aub[m][n][0]); }
#pragma unroll
                for (int r = 1; r < 4; ++r) { const float a = __builtin_amdgcn_exp2f(bflo(aub[m][n][r])); Q[r] = a * Q[r - 1] + bfhi(aub[m][n][r]); P[r] = a * P[r - 1]; }
                float TP = P[3], TQ = Q[3];
                { const float pp = __shfl_up(TP, 16), pq = __shfl_up(TQ, 16); if (fq >= 1) { TQ = TP * pq + TQ; TP = TP * pp; } }
                { const float pp = __shfl_up(TP, 32), pq = __shfl_up(TQ, 32); if (fq >= 2) { TQ = TP * pq + TQ; TP = TP * pp; } }
                float EP = __shfl_up(TP, 16), EQ = __shfl_up(TQ, 16); if (fq == 0) { EP = 1.f; EQ = 0.f; }
                const float hin = EP * hc[n] + EQ;
                const float hnew = TP * hc[n] + TQ;
                hc[n] = __shfl(hnew, fr + 48);
#pragma unroll
                for (int r = 0; r < 4; ++r) { const int t = m * 16 + 4 * fq + r; const float h = P[r] * hin + Q[r];
                    LAS unsigned short* gp = (LAS unsigned short*)(lds + LRU_G + t * 528 + j * 2);
                    const float gt = bf2f(*gp);
                    const float y = h * gt * fast_sigmoid(1.5957691216057308f * (gt + 0.044715f * gt * gt * gt));
                    ssq[r] += y * y; *gp = (unsigned short)f2bf(y); }
            }
#pragma unroll
            for (int r = 0; r < 4; ++r) { float sx = ssq[r]; sx += __shfl_xor(sx, 1); sx += __shfl_xor(sx, 2); sx += __shfl_xor(sx, 4); sx += __shfl_xor(sx, 8);
                if (fr == 0) ((LAS float*)(lds + LRU_PS))[(m * 16 + 4 * fq + r) * 8 + F.wave] = sx; }
            sc_step();
        }
        __syncthreads();
        if (tid < 128) { const LAS float* ps = (const LAS float*)(lds + LRU_PS) + tid * 8; float sx = 0.f;
#pragma unroll
            for (int w = 0; w < 8; ++w) sx += ps[w];
            ((LAS float*)(lds + LRU_RS))[tid] = 1.0f / sqrtf(sx * (1.0f / LRU_HD) + EPS); }
        __syncthreads();
#pragma unroll
        for (int i = 0; i < 8; ++i) { const int p = tid + 512 * i, t = p >> 5, cp = p & 31;
            const v4u v = *(const LAS v4u*)(lds + LRU_G + t * 528 + cp * 16); const float rs = ((const LAS float*)(lds + LRU_RS))[t];
            const float* gp = F.lru_out_g + head * LRU_HD + cp * 8; v4u o;
#pragma unroll
            for (int jx = 0; jx < 4; ++jx) o[jx] = pk2(bflo(v[jx]) * rs * gp[2 * jx], bfhi(v[jx]) * rs * gp[2 * jx + 1]);
            *(v4u*)(ycat + (size_t)(rowbase + t) * DM + head * LRU_HD + cp * 8) = o; }
        __syncthreads();
    }
    while (sc_on && sc_i < 32) { sc_prefetch(); sc_step(); }
}

constexpr int RT_TILE = 0;
constexpr int RT_TILE_W = 2 * 16 * 264 * 2;
constexpr int RT_LOG = 0;
constexpr int RT_ECNT = 8 * RT_TILE_W;
__device__ __forceinline__ void router_phase(const Frame& F) {
    LAS unsigned char* lds = F.lds;
    const float* mod = (const float*)(F.ws + WS_MOD);
    unsigned char* h2 = (unsigned char*)(F.ws + WS_H);
    const bf16* wf = (const bf16*)(F.ws + WS_WRT);
    int* ltok = (int*)(F.ws + WS_LTOK); float* lgate = (float*)(F.ws + WS_LGATE); int* tokslot = (int*)(F.ws + WS_TOKSLOT);
    unsigned* gcnt = (unsigned*)(F.ws + WS_CTL) + CW_GCNT;
    const bf16* x1 = (const bf16*)(F.ws + WS_X1B); const float* rowss = (const float*)(F.ws + WS_ROWSS);
    for (int tb = F.vcu; tb < NTOK / 128; tb += F.G) {
        int tz = threadIdx.x; asm volatile("" : "+v"(tz));
        const int tid = tz, lane = tz & 63, fr = lane & 15, fq = lane >> 4;
        const int tok0 = tb * 128, b = tok0 / SEQ, wtok0 = tok0 + F.wave * 16;
        if (tid < 64) ((LAS int*)(lds + RT_ECNT))[tid] = 0;
        float rstd;
        { const f32x4 p0 = *(const f32x4*)(rowss + (size_t)(wtok0 + fr) * 32 + 8 * fq), p1 = *(const f32x4*)(rowss + (size_t)(wtok0 + fr) * 32 + 8 * fq + 4);
          float ssum = ((p0.x + p0.y) + (p0.z + p0.w)) + ((p1.x + p1.y) + (p1.z + p1.w)); ssum += __shfl_xor(ssum, 16); ssum += __shfl_xor(ssum, 32);
          rstd = 1.0f / sqrtf(ssum * (1.0f / DM) + EPS); }
        LAS unsigned char* tile = lds + RT_TILE + F.wave * RT_TILE_W;
        f32x4 acc[3];
#pragma unroll
        for (int n = 0; n < 3; ++n) acc[n] = (f32x4){0.f, 0.f, 0.f, 0.f};
        struct WSet { bf16x8 w[3][2]; };
        auto wload = [&](WSet& W, int cc, int t) { const bf16* wp = wf + ((size_t)((8 * cc + t) * 3) * 2 * 64 + lane) * 8;
#pragma unroll
            for (int n = 0; n < 3; ++n) { W.w[n][0] = *(const bf16x8*)(wp + (size_t)n * 1024); W.w[n][1] = *(const bf16x8*)(wp + (size_t)n * 1024 + 512); } };
        auto kstep = [&](const WSet& W, int t) { const bf16x8 th = *(const LAS bf16x8*)(tile + fr * 528 + (32 * t + 8 * fq) * 2), tl8 = *(const LAS bf16x8*)(tile + 16 * 528 + fr * 528 + (32 * t + 8 * fq) * 2);
#pragma unroll
            for (int n = 0; n < 3; ++n) { acc[n] = __builtin_amdgcn_mfma_f32_16x16x32_bf16(W.w[n][0], th, acc[n], 0, 0, 0);
                acc[n] = __builtin_amdgcn_mfma_f32_16x16x32_bf16(W.w[n][1], th, acc[n], 0, 0, 0);
                acc[n] = __builtin_amdgcn_mfma_f32_16x16x32_bf16(W.w[n][0], tl8, acc[n], 0, 0, 0); } };
        WSet W0, W1, W2, W3; v2u xb[16], xn[16];
        { const int c0 = (F.wave + F.vcu) & 7; const int kc0 = 256 * c0 + 4 * lane;
#pragma unroll
            for (int r = 0; r < 16; ++r) xb[r] = *(const v2u*)(x1 + (size_t)(wtok0 + r) * DM + kc0);
            wload(W0, c0, 0); wload(W1, c0, 1); wload(W2, c0, 2); }
#pragma unroll 1
        for (int ci = 0; ci < 8; ++ci) {
            const int c = (ci + F.wave + F.vcu) & 7, cn = (ci + 1 + F.wave + F.vcu) & 7;
            const int kc = 256 * c + 4 * lane, kcn = 256 * cn + 4 * lane;
            const f32x4 gsv = *(const f32x4*)(F.g_ffn + kc) * (*(const f32x4*)(mod + (size_t)b * 6 * DM + 4 * DM + kc) + 1.0f), shv = *(const f32x4*)(mod + (size_t)b * 6 * DM + 3 * DM + kc);
#pragma unroll
            for (int r = 0; r < 16; ++r) xn[r] = *(const v2u*)(x1 + (size_t)(wtok0 + r) * DM + kcn);
            __builtin_amdgcn_sched_barrier(0);
#pragma unroll
            for (int r = 0; r < 16; ++r) { const float rs = __builtin_bit_cast(float, __builtin_amdgcn_readlane(__builtin_bit_cast(int, rstd), r));
                const f32x4 v = (f32x4){bflo(xb[r].x), bfhi(xb[r].x), bflo(xb[r].y), bfhi(xb[r].y)} * rs * gsv + shv;
                *(unsigned*)(h2 + (size_t)(wtok0 + r) * DM + kc) = pack4_fp8(v.x * F8S_H2, v.y * F8S_H2, v.z * F8S_H2, v.w * F8S_H2);
                const unsigned a = f2bf(v.x), bq = f2bf(v.y), cq = f2bf(v.z), d = f2bf(v.w);
                v2u hw, lw; hw.x = a | (bq << 16); hw.y = cq | (d << 16); lw.x = pk2(v.x - bf2f(a), v.y - bf2f(bq)); lw.y = pk2(v.z - bf2f(cq), v.w - bf2f(d));
                *(LAS v2u*)(tile + r * 528 + lane * 8) = hw; *(LAS v2u*)(tile + 16 * 528 + r * 528 + lane * 8) = lw; }
#define RT_SB __builtin_amdgcn_sched_barrier(0)
            wload(W3, c, 3); RT_SB; kstep(W0, 0); RT_SB;
            wload(W0, c, 4); RT_SB; kstep(W1, 1); RT_SB;
            wload(W1, c, 5); RT_SB; kstep(W2, 2); RT_SB;
            wload(W2, c, 6); RT_SB; kstep(W3, 3); RT_SB;
            wload(W3, c, 7); RT_SB; kstep(W0, 4); RT_SB;
            wload(W0, cn, 0); RT_SB; kstep(W1, 5); RT_SB;
            wload(W1, cn, 1); RT_SB; kstep(W2, 6); RT_SB;
            wload(W2, cn, 2); RT_SB; kstep(W3, 7); RT_SB;
#undef RT_SB
#pragma unroll
            for (int r = 0; r < 16; ++r) xb[r] = xn[r];
        }
        __syncthreads();
        { const int tl = F.wave * 16 + fr;
#pragma unroll
            for (int n = 0; n < 3; ++n)
#pragma unroll
                for (int r = 0; r < 4; ++r) ((LAS float*)(lds + RT_LOG))[tl * 49 + n * 16 + 4 * fq + r] = acc[n][r]; }
        __syncthreads();
        int e0 = 0, e1 = 0, lp0 = 0, lp1 = 0; float gt0 = 0.f, gt1 = 0.f;
        if (tid < 128) {
            const LAS float* lg = (const LAS float*)(lds + RT_LOG) + tid * 49;
            float gl[4]; int gi = 0; float gm;
#pragma unroll
            for (int g = 0; g < 4; ++g) gl[g] = lg[32 + g] + F.b_rg[g];
            gm = gl[0];
#pragma unroll
            for (int g = 1; g < 4; ++g) if (gl[g] > gm) { gm = gl[g]; gi = g; }
            float gsum = 0.f;
#pragma unroll
            for (int g = 0; g < 4; ++g) gsum += __expf(gl[g] - gm);
            const float gp = 1.0f / gsum;
            float el[8];
#pragma unroll
            for (int j = 0; j < 8; ++j) el[j] = lg[gi * 8 + j] + F.b_re[gi * 8 + j];
            int i0 = 0; float m0 = el[0];
#pragma unroll
            for (int j = 1; j < 8; ++j) if (el[j] > m0) { m0 = el[j]; i0 = j; }
            int i1 = -1; float m1 = -3.0e38f;
#pragma unroll
            for (int j = 0; j < 8; ++j) if (j != i0 && el[j] > m1) { m1 = el[j]; i1 = j; }
            const float ex = __expf(m1 - m0); const float p0 = 1.0f / (1.0f + ex), p1 = ex / (1.0f + ex);
            e0 = gi * 8 + i0; e1 = gi * 8 + i1; gt0 = gp * p0; gt1 = gp * p1;
            lp0 = __hip_atomic_fetch_add((LAS int*)(lds + RT_ECNT) + e0, 1, __ATOMIC_RELAXED, __HIP_MEMORY_SCOPE_WORKGROUP); lp1 = __hip_atomic_fetch_add((LAS int*)(lds + RT_ECNT) + e1, 1, __ATOMIC_RELAXED, __HIP_MEMORY_SCOPE_WORKGROUP);
        }
        __syncthreads();
        if (tid < 32) { const int n = ((LAS int*)(lds + RT_ECNT))[tid]; int base = 0; if (n > 0) base = (int)__hip_atomic_fetch_add(gcnt + tid, (unsigned)n, __ATOMIC_RELAXED, __HIP_MEMORY_SCOPE_AGENT);
            ((LAS int*)(lds + RT_ECNT))[32 + tid] = base; }
        __syncthreads();
        if (tid < 128) { const int tk = tok0 + tid;
            const int q0 = ((LAS int*)(lds + RT_ECNT))[32 + e0] + lp0, q1 = ((LAS int*)(lds + RT_ECNT))[32 + e1] + lp1;
            ltok[e0 * LIST_CAP + q0] = tk; ltok[e1 * LIST_CAP + q1] = tk; *(f32x2*)(lgate + (size_t)tk * 2) = (f32x2){gt0, gt1};
            tokslot[tk * 2] = (e0 << 16) | q0; tokslot[tk * 2 + 1] = (e1 << 16) | q1; }
        __syncthreads();
    }
}

__device__ __forceinline__ void moe_table(const Frame& F) {
    LAS int* tab = (LAS int*)(F.lds + LDS_TAB);
    const unsigned* gcnt = (const unsigned*)(F.ws + WS_CTL) + CW_GCNT;
    if (F.tid < 32) tab[64 + F.tid] = (int)__hip_atomic_load(gcnt + F.tid, __ATOMIC_RELAXED, __HIP_MEMORY_SCOPE_AGENT);
    __syncthreads();
    if (F.tid == 0) { int acc = 0; for (int e = 0; e < 32; ++e) { tab[e] = acc; acc += (tab[64 + e] + 255) >> 8; } tab[32] = acc; }
    __syncthreads();
    if (F.tid < MAX_TILES) { int e = 0; for (int j = 1; j < 32; ++j) e = (tab[j] <= F.tid) ? j : e; tab[128 + F.tid] = e; }
    __syncthreads();
}

__device__ __forceinline__ void final_phase(const Frame& F) {
    const LAS int* tab = (const LAS int*)(F.lds + LDS_TAB);
    const float* mod = (const float*)(F.ws + WS_MOD); const int* tokslot = (const int*)(F.ws + WS_TOKSLOT); const float* tokgate = (const float*)(F.ws + WS_LGATE); const unsigned char* yexp = (const unsigned char*)(F.ws + WS_YEXP);
    const int gw = F.vcu * 8 + F.wave, NGW = F.G * 8; constexpr int RPW = NTOK / 2048;
    for (int chunk = gw; chunk < 2048; chunk += NGW) {
        const int row_begin = chunk * RPW, b = row_begin / SEQ;
        f32x4 g2[8], gf[8];
#pragma unroll
        for (int j = 0; j < 8; ++j) { const int c = 4 * F.lane + 256 * j; g2[j] = *(const f32x4*)(mod + (size_t)b * 6 * DM + 5 * DM + c); gf[j] = *(const f32x4*)(F.g_final + c); }
        int sra, srb; float gta, gtb;
        { const int rr = F.lane & 15; const v2u ts = *(const v2u*)(tokslot + (size_t)(row_begin + rr) * 2); const f32x2 gg = *(const f32x2*)(tokgate + (size_t)(row_begin + rr) * 2);
          sra = tab[ts.x >> 16] * 256 + (int)(ts.x & 0xffffu); srb = tab[ts.y >> 16] * 256 + (int)(ts.y & 0xffffu); gta = gg.x; gtb = gg.y; }
#pragma unroll 2
        for (int r = 0; r < RPW; ++r) {
            const int row = row_begin + r;
            const size_t ra = (size_t)__builtin_amdgcn_readlane(sra, r), rb = (size_t)__builtin_amdgcn_readlane(srb, r);
            const float ga = __builtin_bit_cast(float, __builtin_amdgcn_readlane(__builtin_bit_cast(int, gta), r)) * (1.0f / F8S_Y), gb = __builtin_bit_cast(float, __builtin_amdgcn_readlane(__builtin_bit_cast(int, gtb), r)) * (1.0f / F8S_Y);
            const v2u* xr = (const v2u*)((const bf16*)(F.ws + WS_X1B) + (size_t)row * DM) + F.lane;
            const unsigned* ya = (const unsigned*)(yexp + ra * DM) + F.lane; const unsigned* yb = (const unsigned*)(yexp + rb * DM) + F.lane;
            f32x4 v[8]; float s = 0.f;
#pragma unroll
            for (int j = 0; j < 8; ++j) { const v2u xw = xr[64 * j]; const f32x4 xv = {bflo(xw.x), bfhi(xw.x), bflo(xw.y), bfhi(xw.y)}; const int a = (int)ya[64 * j], bq = (int)yb[64 * j];
                f32x4 f; f.x = ga * __builtin_amdgcn_cvt_f32_fp8(a, 0) + gb * __builtin_amdgcn_cvt_f32_fp8(bq, 0); f.y = ga * __builtin_amdgcn_cvt_f32_fp8(a, 1) + gb * __builtin_amdgcn_cvt_f32_fp8(bq, 1);
                f.z = ga * __builtin_amdgcn_cvt_f32_fp8(a, 2) + gb * __builtin_amdgcn_cvt_f32_fp8(bq, 2); f.w = ga * __builtin_amdgcn_cvt_f32_fp8(a, 3) + gb * __builtin_amdgcn_cvt_f32_fp8(bq, 3);
                v[j] = xv + g2[j] * f; s += (v[j].x * v[j].x + v[j].y * v[j].y) + (v[j].z * v[j].z + v[j].w * v[j].w); }
            const float rstd = 1.0f / sqrtf(wave_sum(s) * (1.0f / DM) + EPS);
            f32x4* o = (f32x4*)(F.out + (size_t)row * DM) + F.lane;
#pragma unroll
            for (int j = 0; j < 8; ++j) o[64 * j] = v[j] * rstd * gf[j];
        }
    }
}

struct Args { const float* in[26]; float* out; unsigned char* ws; int ph_lo, ph_hi; };
__global__ void __launch_bounds__(512, 2) hymba_fwd(Args args) {
    extern __shared__ __attribute__((aligned(16))) unsigned char lds_raw[];
    Frame F;
    F.lds = (LAS unsigned char*)lds_raw;
    F.tid = threadIdx.x; F.lane = F.tid & 63; F.wave = __builtin_amdgcn_readfirstlane(F.tid >> 6);
    F.G = gridDim.x; { const int bx = blockIdx.x; F.vcu = (F.G % 8 == 0) ? (bx % 8) * (F.G / 8) + bx / 8 : bx; }
    F.ws = args.ws; F.out = args.out;
    F.x = args.in[0]; F.c = args.in[1]; F.w_ada = args.in[2]; F.b_ada = args.in[3]; F.g_mix = args.in[4]; F.w_in = args.in[5]; F.lru_conv_w = args.in[6]; F.lru_conv_b = args.in[7];
    F.lru_w_a = args.in[8]; F.lru_b_a = args.in[9]; F.lru_w_x = args.in[10]; F.lru_b_x = args.in[11]; F.lru_lambda = args.in[12]; F.lru_out_g = args.in[13]; F.sc_conv_w = args.in[14];
    F.sc_out_g = args.in[15]; F.w_out = args.in[16]; F.g_ffn = args.in[17]; F.w_rg = args.in[18]; F.b_rg = args.in[19]; F.w_re = args.in[20]; F.b_re = args.in[21];
    F.w1 = args.in[22]; F.w3 = args.in[23]; F.w2 = args.in[24]; F.g_final = args.in[25];
    volatile LAS unsigned* MISC = (volatile LAS unsigned*)(F.lds + LDS_MISC);
    if (F.tid < 64) MISC[F.tid] = 0u;
    __syncthreads();
    unsigned* ctl = (unsigned*)(F.ws + WS_CTL);
    XcdBarrier bar; bar.bar = ctl + CW_BAR; bar.x = 0; bar.st = nullptr;
    if (MK_N_LAUNCHES == 1) bar = xcd_barrier_post(ctl + CW_BAR, MISC + 8);
#define GRID_BAR() do { if (MK_N_LAUNCHES == 1) xcd_barrier(bar); } while (0)
    const int lo = args.ph_lo, hi = args.ph_hi;
#ifndef PH_MASK
#define PH_MASK 0x3ff
#endif
#define IN(k) (((PH_MASK >> (k)) & 1) && lo <= (k) && (k) < hi)
#define BOTH(k) (IN(k) && IN((k) + 1))
    const float* mod = (const float*)(F.ws + WS_MOD);

    if (IN(0)) { { phase0(F); } if (BOTH(0)) GRID_BAR(); }
    if (IN(1)) { { const int gw = F.vcu * 8 + F.wave, NGW = F.G * 8;
        for (int chunk = gw; chunk < 2048; chunk += NGW) norm_rows(F, F.x, F.g_mix, mod, mod + DM, (bf16*)(F.ws + WS_H), chunk * 16, 16, (LAS float*)F.lds, false); }
        if (BOTH(1)) GRID_BAR();
    }
    if (IN(2)) { { pg8::DenseOrder<DM * 2> S; S.init(F.ws + WS_H, F.ws + WS_WIN, NTOK, IN_COLS, F.G, (int)blockIdx.x);
        pg8::EpiBf16 E{(bf16*)(F.ws + WS_PROJ), IN_COLS, 3072};
        pg8::gemm_phase<DM * 2, false, false>(F.lds, S, E, nullptr); }
        if (BOTH(2)) GRID_BAR();
    }
    if (IN(3)) { { lru_phase<false>(F); } if (BOTH(3)) GRID_BAR(); }
    if (IN(4)) { { lru_final_phase(F); sconv_phase(F, 1); } if (BOTH(4)) GRID_BAR(); }
    if (IN(5)) { {
        pg8::DenseOrder<DM * 2> S; S.init(F.ws + WS_YCAT, F.ws + WS_WOUT, NTOK, DM, F.G, (int)blockIdx.x);
        pg8::EpiResid E{F.x, (bf16*)(F.ws + WS_X1B), mod + 2 * DM, (float*)(F.ws + WS_ROWSS)};
        pg8::gemm_phase<DM * 2, false, false>(F.lds, S, E, nullptr); }
        if (BOTH(5)) GRID_BAR();
    }
    if (IN(6)) { { router_phase(F); } if (BOTH(6)) GRID_BAR(); }
    if (IN(7)) { { moe_table(F);
        pg8::MoeOrder<DM, 8, 128, true> S{(const char*)(F.ws + WS_H), (const char*)(F.ws + WS_W13), (const LAS int*)(F.lds + LDS_TAB), F.G, (int)blockIdx.x, (size_t)DM * DM};
        pg8::EpiSwiglu E{(unsigned char*)(F.ws + WS_HID)};
        pg8::gemm_phase<DM, true, true>(F.lds, S, E, (const int*)(F.ws + WS_LTOK)); }
        if (BOTH(7)) GRID_BAR();
    }
    if (IN(8)) { { moe_table(F);
        pg8::MoeOrder<FF, 8, 256, false> S{(const char*)(F.ws + WS_HID), (const char*)(F.ws + WS_W2), (const LAS int*)(F.lds + LDS_TAB), F.G, (int)blockIdx.x, (size_t)DM * FF};
        pg8::EpiDown E{(unsigned char*)(F.ws + WS_YEXP)};
        pg8::gemm_phase<FF, true, false>(F.lds, S, E, nullptr); }
        if (BOTH(8)) GRID_BAR();
    }
    if (IN(9)) { moe_table(F); final_phase(F); }
#undef IN
#undef BOTH
}

extern "C" void kernel_launch(void* const* d_in, const int* in_sizes, int n_in, void* d_out, int out_size, void* d_ws, size_t ws_size, hipStream_t stream) {
    static int grid = 0;
    if (grid == 0) {
        if (n_in != 26 || in_sizes[0] != NTOK * DM || out_size != NTOK * DM || ws_size < WS_END) {
            fprintf(stderr, "kernel_launch: unexpected problem (n_in %d, in0 %d, out %d, ws %zu; need ws >= %zu)\n", n_in, n_in > 0 ? in_sizes[0] : -1, out_size, ws_size, (size_t)WS_END); grid = -1; return; }
        int dev = 0, cus = 0, per_cu = 0;
        if (hipGetDevice(&dev) != hipSuccess || hipDeviceGetAttribute(&cus, hipDeviceAttributeMultiprocessorCount, dev) != hipSuccess) { grid = -1; return; }
        if (hipFuncSetAttribute((const void*)hymba_fwd, hipFuncAttributeMaxDynamicSharedMemorySize, LDS_BYTES) != hipSuccess) { fprintf(stderr, "kernel_launch: hipFuncSetAttribute failed\n"); grid = -1; return; }
        if (hipOccupancyMaxActiveBlocksPerMultiprocessor(&per_cu, (const void*)hymba_fwd, 512, LDS_BYTES) != hipSuccess || per_cu < 1)
            fprintf(stderr, "kernel_launch: occupancy query reports %d workgroups per CU\n", per_cu);
        (void)hipGetLastError();
        grid = cus;
    }
    if (grid < 0) return;
    if (hipMemsetAsync((char*)d_ws + WS_CTL, 0, CTL_ZERO_BYTES, stream) != hipSuccess) { fprintf(stderr, "kernel_launch: memset failed\n"); return; }
    Args a{};
    for (int i = 0; i < 26; ++i) a.in[i] = (const float*)d_in[i];
    a.out = (float*)d_out; a.ws = (unsigned char*)d_ws;
    if (MK_N_LAUNCHES == 1) {
        a.ph_lo = 0; a.ph_hi = N_PHASES;
        hipLaunchKernelGGL(hymba_fwd, dim3(grid), dim3(512), LDS_BYTES, stream, a);
    } else {
        for (int p = 0; p < N_PHASES; ++p) { a.ph_lo = p; a.ph_hi = p + 1; hipLaunchKernelGGL(hymba_fwd, dim3(grid), dim3(512), LDS_BYTES, stream, a); }
    }
    const hipError_t le = hipPeekAtLastError();
    if (le != hipSuccess) fprintf(stderr, "kernel_launch: launch failed: %s\n", hipGetErrorName(le));
}
```
